# Optimizing an MI355X kernel written in HIP

```python
import jax, jax.numpy as jnp
from jax import lax
import numpy as np

D_MODEL = 1024
BATCH = 4
SEQ = 8192
DEPTH = 4

N_HEADS = 8
N_KV_HEADS = 2
HEAD_DIM = 64
ATTN_WIDTH = N_HEADS * HEAD_DIM
KV_WIDTH = N_KV_HEADS * HEAD_DIM
WINDOW = 128
BLOCK = 128
ROPE_DIM = HEAD_DIM // 4
ROPE_THETA = 500000.0
CONV_WIDTH = D_MODEL - ATTN_WIDTH
CONV_K = 3
MIX_WIDTH = ATTN_WIDTH + CONV_WIDTH
IN_WIDTH = ATTN_WIDTH + 2 * KV_WIDTH + 3 * CONV_WIDTH
SPLITS = (ATTN_WIDTH, ATTN_WIDTH + KV_WIDTH, ATTN_WIDTH + 2 * KV_WIDTH,
          ATTN_WIDTH + 2 * KV_WIDTH + CONV_WIDTH, ATTN_WIDTH + 2 * KV_WIDTH + 2 * CONV_WIDTH)
N_EXPERT_GROUPS = 4
EXPERTS_PER_GROUP = 8
N_EXPERTS = N_EXPERT_GROUPS * EXPERTS_PER_GROUP
TOP_K = 2
D_EXPERT = 512
MOE_BLOCK = 256
EPS = 1e-6
NEG_INF = -1e30

kernel_name = "hymba_style_hybrid_encoder"


def rmsnorm(x, g):
    xf = x.astype(jnp.float32)
    y = xf * lax.rsqrt(jnp.mean(xf * xf, axis=-1, keepdims=True) + EPS)
    return (y * g.astype(jnp.float32)).astype(x.dtype)


def rope_tables(seq):
    pos = jnp.arange(seq, dtype=jnp.float32)
    inv_freq = ROPE_THETA ** (-jnp.arange(0, ROPE_DIM, 2, dtype=jnp.float32) / ROPE_DIM)
    ang = pos[:, None] * inv_freq[None, :]
    return jnp.cos(ang)[:, None, :], jnp.sin(ang)[:, None, :]


def partial_rope(x, cos, sin):
    half = ROPE_DIM // 2
    xf = x.astype(jnp.float32)
    x1, x2, rest = xf[..., :half], xf[..., half:ROPE_DIM], xf[..., ROPE_DIM:]
    out = jnp.concatenate([x1 * cos - x2 * sin, x2 * cos + x1 * sin, rest], axis=-1)
    return out.astype(x.dtype)


def windowed_gqa_with_sink(q, k, v, sink):
    b, s = q.shape[0], q.shape[1]
    nb = s // BLOCK
    grp = N_HEADS // N_KV_HEADS
    qb = q.reshape(b, nb, BLOCK, N_KV_HEADS, grp, HEAD_DIM)

    def band(t):
        tp = jnp.pad(t, ((0, 0), (BLOCK, BLOCK), (0, 0), (0, 0)))
        tp = tp.reshape(b, nb + 2, BLOCK, N_KV_HEADS, HEAD_DIM)
        return jnp.concatenate([tp[:, :-2], tp[:, 1:-1], tp[:, 2:]], axis=2)

    kb, vb = band(k), band(v)
    scores = jnp.einsum('bnqhgd,bnkhd->bnhgqk', qb, kb,
                        preferred_element_type=jnp.float32) * (HEAD_DIM ** -0.5)
    qi = jnp.arange(BLOCK)[:, None]
    kj = jnp.arange(3 * BLOCK)[None, :]
    k_pos = (jnp.arange(nb)[:, None, None] - 1) * BLOCK + kj
    mask = (jnp.abs(kj - BLOCK - qi) <= WINDOW) & (k_pos >= 0) & (k_pos < s)
    scores = jnp.where(mask[None, :, None, None], scores, NEG_INF)
    sink_col = jnp.broadcast_to(
        sink.astype(jnp.float32).reshape(N_KV_HEADS, grp)[None, None, :, :, None, None],
        scores.shape[:-1] + (1,))
    probs = jax.nn.softmax(jnp.concatenate([scores, sink_col], axis=-1), axis=-1)[..., :-1]
    out = jnp.einsum('bnhgqk,bnkhd->bnqhgd', probs.astype(v.dtype), vb)
    return out.reshape(b, s, ATTN_WIDTH)


def centred_short_conv(u, w):
    up = jnp.pad(u, ((0, 0), (1, 1), (0, 0)))
    return up[:, :-2] * w[0] + up[:, 1:-1] * w[1] + up[:, 2:] * w[2]


def hybrid_mixer(h, w_in, sink, conv_w, g_attn, g_conv, w_out, cos, sin):
    b, s, _ = h.shape
    proj = h @ w_in
    q, k, v, gate_b, gate_c, u = jnp.split(proj, SPLITS, axis=-1)
    q = partial_rope(q.reshape(b, s, N_HEADS, HEAD_DIM), cos, sin)
    k = partial_rope(k.reshape(b, s, N_KV_HEADS, HEAD_DIM), cos, sin)
    v = v.reshape(b, s, N_KV_HEADS, HEAD_DIM)
    y_attn = windowed_gqa_with_sink(q, k, v, sink)
    y_conv = gate_b * centred_short_conv(gate_c * u, conv_w)
    y = jnp.concatenate([rmsnorm(y_attn, g_attn), rmsnorm(y_conv, g_conv)], axis=-1)
    return y @ w_out


def hierarchical_moe(h, w_rg, b_rg, w_re, b_re, w_gate, w_up, w_down):
    b, s, d = h.shape
    t = b * s
    xf = h.reshape(t, d)
    group_logits = (xf @ w_rg).astype(jnp.float32) + b_rg.astype(jnp.float32)
    group_prob = jax.nn.softmax(group_logits, axis=-1)
    grp = jnp.argmax(group_logits, axis=-1)
    p_grp = jnp.take_along_axis(group_prob, grp[:, None], axis=-1)
    expert_logits = ((xf @ w_re).astype(jnp.float32) + b_re.astype(jnp.float32)
                     ).reshape(t, N_EXPERT_GROUPS, EXPERTS_PER_GROUP)
    in_group = jnp.take_along_axis(expert_logits, grp[:, None, None], axis=1)[:, 0]
    top_logit, top_local = lax.top_k(in_group, TOP_K)
    gates = p_grp * jax.nn.softmax(top_logit, axis=-1)
    experts = grp[:, None] * EXPERTS_PER_GROUP + top_local

    a = t * TOP_K
    flat_e = experts.reshape(a)
    flat_tok = jnp.arange(a, dtype=jnp.int32) // TOP_K
    flat_g = gates.reshape(a)
    order = jnp.argsort(flat_e)
    e_sorted, tok_sorted, g_sorted = flat_e[order], flat_tok[order], flat_g[order]
    counts = jnp.bincount(flat_e, length=N_EXPERTS)
    starts = jnp.cumsum(counts) - counts
    padded = (counts + MOE_BLOCK - 1) // MOE_BLOCK * MOE_BLOCK
    padded_end = jnp.cumsum(padded)
    dest = (padded_end - padded)[e_sorted] + jnp.arange(a) - starts[e_sorted]
    n_blocks = -(-a // MOE_BLOCK) + N_EXPERTS
    cap = n_blocks * MOE_BLOCK
    slot_tok = jnp.zeros((cap,), jnp.int32).at[dest].set(tok_sorted)
    block_expert = jnp.minimum(
        jnp.searchsorted(padded_end, jnp.arange(n_blocks) * MOE_BLOCK, side='right'),
        N_EXPERTS - 1)
    x_slots = xf[slot_tok].reshape(n_blocks, MOE_BLOCK, d)

    def expert_block(args):
        xb, e = args
        return (jax.nn.silu(xb @ w_gate[e]) * (xb @ w_up[e])) @ w_down[e]

    y_slots = lax.map(expert_block, (x_slots, block_expert)).reshape(cap, d)
    y_assign = y_slots[dest] * g_sorted[:, None].astype(h.dtype)
    y = jax.ops.segment_sum(y_assign, tok_sorted, num_segments=t)
    return y.reshape(b, s, d)


def setup_inputs(seed: int = 0) -> dict:
    key = jax.random.key(seed)
    ks = jax.random.split(key, 17)
    f32 = jnp.float32
    nrm = lambda k, shape, scale: jax.random.normal(k, shape, f32) * scale
    res_scale = (2.0 * DEPTH) ** -0.5
    return {
        "x": nrm(ks[0], (BATCH, SEQ, D_MODEL), 1.0),
        "norm_mix": 1.0 + nrm(ks[1], (DEPTH, D_MODEL), 0.02),
        "w_in": nrm(ks[2], (DEPTH, D_MODEL, IN_WIDTH), D_MODEL ** -0.5),
        "attn_sink": nrm(ks[3], (DEPTH, N_HEADS), 0.5),
        "conv_w": nrm(ks[4], (DEPTH, CONV_K, CONV_WIDTH), CONV_K ** -0.5),
        "norm_attn_out": 1.0 + nrm(ks[5], (DEPTH, ATTN_WIDTH), 0.02),
        "norm_conv_out": 1.0 + nrm(ks[6], (DEPTH, CONV_WIDTH), 0.02),
        "w_out": nrm(ks[7], (DEPTH, MIX_WIDTH, D_MODEL), MIX_WIDTH ** -0.5 * res_scale),
        "norm_ffn": 1.0 + nrm(ks[8], (DEPTH, D_MODEL), 0.02),
        "w_router_group": nrm(ks[9], (DEPTH, D_MODEL, N_EXPERT_GROUPS), D_MODEL ** -0.5),
        "b_router_group": nrm(ks[10], (DEPTH, N_EXPERT_GROUPS), 0.01),
        "w_router_expert": nrm(ks[11], (DEPTH, D_MODEL, N_EXPERTS), D_MODEL ** -0.5),
        "b_router_expert": nrm(ks[12], (DEPTH, N_EXPERTS), 0.01),
        "w_expert_gate": nrm(ks[13], (DEPTH, N_EXPERTS, D_MODEL, D_EXPERT), D_MODEL ** -0.5),
        "w_expert_up": nrm(ks[14], (DEPTH, N_EXPERTS, D_MODEL, D_EXPERT), D_MODEL ** -0.5),
        "w_expert_down": nrm(ks[15], (DEPTH, N_EXPERTS, D_EXPERT, D_MODEL), D_EXPERT ** -0.5 * res_scale),
        "norm_final": 1.0 + nrm(ks[16], (D_MODEL,), 0.02),
    }


def reference(x, norm_mix, w_in, attn_sink, conv_w, norm_attn_out, norm_conv_out, w_out,
              norm_ffn, w_router_group, b_router_group, w_router_expert, b_router_expert,
              w_expert_gate, w_expert_up, w_expert_down, norm_final):
    cos, sin = rope_tables(x.shape[1])
    for l in range(DEPTH):
        x = x + hybrid_mixer(rmsnorm(x, norm_mix[l]), w_in[l], attn_sink[l], conv_w[l],
                             norm_attn_out[l], norm_conv_out[l], w_out[l], cos, sin)
        x = x + hierarchical_moe(rmsnorm(x, norm_ffn[l]), w_router_group[l], b_router_group[l],
                                 w_router_expert[l], b_router_expert[l], w_expert_gate[l],
                                 w_expert_up[l], w_expert_down[l])
    return rmsnorm(x, norm_final)
```

```cpp
#include <hip/hip_runtime.h>
#include <cstdio>
#include <cstdint>
#include <cstring>

#ifndef MK_ONE_LAUNCH
#define MK_ONE_LAUNCH 1
#endif

constexpr int D = 1024, BATCH = 4, SEQ = 8192, T = BATCH * SEQ, DEPTH = 4;
constexpr int NH = 8, HD = 64, AW = 512, CW = 512, INW = 2304;
constexpr int C_Q = 0, C_K = 512, C_V = 640, C_B = 768, C_C = 1280, C_U = 1792;
constexpr int PW = 1792, P_CU = 1280;
constexpr int NE = 32, NG = 4, DE = 512;
constexpr int WIN = 128;
constexpr float EPS = 1e-6f;
constexpr float QSCALE = 0.125f * 1.4426950408889634f;
constexpr float LOG2E = 1.4426950408889634f;
constexpr int LCAP = T;
constexpr int MAXSLOTS = 2 * T + NE * 256;

#define LAS __attribute__((address_space(3)))
#define GAS __attribute__((address_space(1)))
typedef unsigned short bf16_t;
typedef short bf16x8 __attribute__((ext_vector_type(8)));
typedef float f32x4 __attribute__((ext_vector_type(4)));
typedef unsigned u32x4 __attribute__((ext_vector_type(4)));
typedef unsigned u32x2 __attribute__((ext_vector_type(2)));

constexpr size_t MiB = 1u << 20;
constexpr size_t WS_CTL = 0, CTL_ZERO_BYTES = 128 * 1024;
constexpr size_t WS_CS = 1 * MiB;
constexpr size_t WS_RSTD = 2 * MiB;
constexpr size_t WS_SS = 3 * MiB;
constexpr size_t WS_GATES = 5 * MiB;
constexpr size_t WS_RSA = 5 * MiB + 512 * 1024;
constexpr size_t WS_LISTS = 6 * MiB;
constexpr size_t WS_WR = 10 * MiB;
constexpr size_t WS_WIN = 12 * MiB;
constexpr size_t WS_WOUT = 30 * MiB;
constexpr size_t WS_WGU = 40 * MiB;
constexpr size_t WS_WDN = 296 * MiB;
constexpr size_t WS_XB = 424 * MiB;
constexpr size_t WS_PROJ = 488 * MiB;
constexpr size_t WS_Y = 632 * MiB;
constexpr size_t WS_ACT = 696 * MiB;
constexpr size_t WS_YK = 768 * MiB;
constexpr size_t WS_DUMMY = 896 * MiB;
constexpr size_t WS_END = 897 * MiB;
constexpr int CW_BAR = 4096;
constexpr int CW_CONV = 8192;
constexpr int CW_CNT = 16384;

constexpr int RING_BYTES = 131072;
constexpr int MISC_OFF = RING_BYTES;
constexpr int LDS_BYTES = 147456;

__device__ __forceinline__ float bf2f(unsigned short b) { return __uint_as_float((unsigned)b << 16); }
__device__ __forceinline__ float bflo(unsigned w) { return __uint_as_float(w << 16); }
__device__ __forceinline__ float bfhi(unsigned w) { return __uint_as_float(w & 0xffff0000u); }
typedef float f32x2_t __attribute__((ext_vector_type(2)));
typedef __bf16 bf16x2_t __attribute__((ext_vector_type(2)));
__device__ __forceinline__ unsigned cvt_pk_bf16(float lo, float hi) { const f32x2_t v = {lo, hi}; const bf16x2_t b = __builtin_convertvector(v, bf16x2_t); return __builtin_bit_cast(unsigned, b); }
__device__ __forceinline__ float wave_sum(float v) {
#define WS_DPP(x, ctrl) __uint_as_float((unsigned)__builtin_amdgcn_update_dpp(0, (int)__float_as_uint(x), ctrl, 0xf, 0xf, false))
    v += WS_DPP(v, 0xB1); v += WS_DPP(v, 0x4E); v += WS_DPP(v, 0x124); v += WS_DPP(v, 0x128);
#undef WS_DPP
    { auto rr = __builtin_amdgcn_permlane16_swap(__float_as_uint(v), __float_as_uint(v), false, false); v = __uint_as_float(rr[0]) + __uint_as_float(rr[1]); }
    { auto rr = __builtin_amdgcn_permlane32_swap(__float_as_uint(v), __float_as_uint(v), false, false); v = __uint_as_float(rr[0]) + __uint_as_float(rr[1]); }
    return v;
}
__device__ __forceinline__ int lane_id() { int r; asm volatile("v_mbcnt_lo_u32_b32 %0, -1, 0\n\tv_mbcnt_hi_u32_b32 %0, -1, %0" : "=&v"(r)); return r; }
#define LDS_WAIT() asm volatile("s_waitcnt lgkmcnt(0)" ::: "memory")
#define VM_WAIT() asm volatile("s_waitcnt vmcnt(0)" ::: "memory")

namespace pg8 {
constexpr int BM = 256, BK = 64, HALF = 128, HTB = HALF * BK * 2, STAGE_BYTES = 8 * HTB, NXCD = 8, WGM = 8;
__host__ __device__ __forceinline__ int lds_byte(int r, int c) { const int st = (r >> 4) * 2 + (c >> 5), rr = r & 15, cc = c & 31, ob = rr * 64 + cc * 2; return st * 1024 + (ob ^ (((ob >> 9) & 1) << 5)); }
__host__ __device__ __forceinline__ void stage_rc(int b, int& R, int& C) { const int st = b / 1024, sb = b % 1024, swz = sb ^ (((sb >> 9) & 1) << 5); R = (st >> 1) * 16 + swz / 64; C = (st & 1) * 32 + (swz % 64) / 2; }
__host__ __device__ __forceinline__ int perm32(int rho) { const int n = rho >> 4, i = rho & 15; return 8 * (i >> 2) + 4 * n + (i & 3); }

struct Unit { int pm, pn, e, lt, nvalid; };

__device__ __forceinline__ bool tile_order(int L, int nM, int nN, int& pm, int& pn) {
    const int nwg = nM * nN; if (L >= nwg) return false;
    int wgid = L; { const int q = nwg / NXCD, r = nwg % NXCD, xcd = wgid % NXCD, off = wgid / NXCD; wgid = (xcd < r ? xcd * (q + 1) : r * (q + 1) + (xcd - r) * q) + off; }
    const int nig = WGM * nN, gid = wgid / nig, fm = gid * WGM, gsz = (nM - fm) < WGM ? (nM - fm) : WGM;
    pm = fm + ((wgid % nig) % gsz); pn = (wgid % nig) / gsz; return true;
}

template <class Epi, class Sched, bool GATHER, bool TABLE>
__device__ __forceinline__ unsigned gemm_phase(LAS unsigned char* lds, volatile LAS unsigned* tab, const int K, const Sched& S, const Epi& E, const int wave, unsigned* peek = nullptr) {
    int tid = wave * 64 + lane_id(); asm volatile("" : "+v"(tid));
    const int wid = wave, lane = tid & 63, wr = wid >> 2, wc = wid & 3, fr = lane & 15, fq = lane >> 4;
    const int nt = K / BK;
    constexpr int NST = Epi::NSTORE;
    unsigned voffB[2][2], cvo[2][2];
    {   int RR[2], CC[2];
#pragma unroll
        for (int i = 0; i < 2; ++i) { stage_rc(tid * 16 + i * 8192, RR[i], CC[i]); const int Rb = (RR[i] & ~31) + perm32(RR[i] & 31);
            voffB[0][i] = (unsigned)((64 * (RR[i] >> 5) + perm32(RR[i] & 31)) * K + CC[i]) * 2u; voffB[1][i] = voffB[0][i] + (unsigned)(32 * K * 2); (void)Rb;
            cvo[0][i] = (unsigned)(RR[i] * K + CC[i]) * 2u; cvo[1][i] = (unsigned)((RR[i] + HALF) * K + CC[i]) * 2u; } }
#define PG8_GATHER_VO(dst, tbl) do { int tid2_ = tid; asm volatile("" : "+v"(tid2_)); _Pragma("unroll") for (int i_ = 0; i_ < 2; ++i_) { int R_, C_; stage_rc(tid2_ * 16 + i_ * 8192, R_, C_); \
        _Pragma("unroll") for (int h_ = 0; h_ < 2; ++h_) dst[h_][i_] = (((tbl)[h_ * HALF + R_] & 0xfffeu) << 10) + (unsigned)C_ * 2u; } } while (0)
    const size_t kstep = (size_t)(BK * 2);
    const size_t hstep = (size_t)HALF * K * 2;
    const unsigned ldsw = (unsigned)wid * 1024u;
    const unsigned ldsbase = (unsigned)__builtin_amdgcn_readfirstlane((int)((unsigned)(uintptr_t)lds + ldsw));
    const int aoff = lds_byte(wr * 64 + fr, fq * 8), boff = lds_byte(wc * 32 + fr, fq * 8);
#define PG8_SA(b, h) (((b) * 2 + (h)) * HTB)
#define PG8_SB(b, h) ((4 + (b) * 2 + (h)) * HTB)
#define PG8_GLDS(gbase, voff32, ldsdst) do { unsigned keep_; asm volatile("s_mov_b32 %0, m0\n\ts_mov_b32 m0, %3\n\ts_nop 4\n\tglobal_load_lds_dwordx4 %1, %2\n\ts_mov_b32 m0, %0" \
        : "=&s"(keep_) : "v"(voff32), "s"(gbase), "s"(ldsdst) : "memory"); } while (0)
#define PG8_STAGE(bufoff, gbase, voff) do { _Pragma("unroll") for (int _i = 0; _i < 2; ++_i) \
        PG8_GLDS((const char*)(gbase), (voff)[_i], ldsbase + (unsigned)((bufoff) + _i * 8192)); } while (0)
#define PG8_LDA(dst, b, h) do { _Pragma("unroll") for (int m = 0; m < 4; ++m) _Pragma("unroll") for (int k = 0; k < 2; ++k) dst[m][k] = *(const LAS bf16x8*)(lds + PG8_SA(b, h) + aoff + m * 2048 + k * 1024); } while (0)
#define PG8_LDB(dst, b, h) do { _Pragma("unroll") for (int n = 0; n < 2; ++n) _Pragma("unroll") for (int k = 0; k < 2; ++k) dst[n][k] = *(const LAS bf16x8*)(lds + PG8_SB(b, h) + boff + n * 2048 + k * 1024); } while (0)
#define PG8_MMA(ai, bj, At, Bt) do { __builtin_amdgcn_s_setprio(1); _Pragma("unroll") for (int m = 0; m < 4; ++m) _Pragma("unroll") for (int n = 0; n < 2; ++n) _Pragma("unroll") for (int k = 0; k < 2; ++k) \
        acc[ai][bj][m][n] = __builtin_amdgcn_mfma_f32_16x16x32_bf16(Bt[n][k], At[m][k], acc[ai][bj][m][n], 0, 0, 0); __builtin_amdgcn_s_setprio(0); } while (0)
#define PG8_WAIT_V(n) asm volatile("s_waitcnt vmcnt(" #n ")" ::: "memory")
#define PG8_WAIT_VF(n) do { if (fresh) asm volatile("s_waitcnt vmcnt(%0)" :: "n"((n) + NST) : "memory"); else asm volatile("s_waitcnt vmcnt(8)" ::: "memory"); } while (0)
#define PG8_WAIT_L(n) asm volatile("s_waitcnt lgkmcnt(" #n ")" ::: "memory")
#define PG8_BAR __builtin_amdgcn_s_barrier()
#define PG8_SCHED __builtin_amdgcn_sched_barrier(0)
    Unit cur, nxt; int ui = 0;
    unsigned pk = 0u;
    if (!S.next(0, cur)) return 0u;
    f32x4 acc[2][2][4][2];
#pragma unroll
    for (int a = 0; a < 2; ++a)
#pragma unroll
        for (int b = 0; b < 2; ++b)
#pragma unroll
            for (int m = 0; m < 4; ++m)
#pragma unroll
                for (int n = 0; n < 2; ++n) acc[a][b][m][n] = (f32x4){0.f, 0.f, 0.f, 0.f};
    bf16x8 At[4][2], B0[2][2], B1[2][2];
    const char* cA = S.a_ptr(cur); const char* cB = S.b_ptr(cur);
    bool has_next = S.next(1, nxt);
    unsigned rinfo = 0u, rinfo0 = 0u;
    PG8_STAGE(PG8_SB(0, 0), cB, voffB[0]); PG8_STAGE(PG8_SB(0, 1), cB, voffB[1]);
    if constexpr (TABLE) {
        if (tid < 256) { rinfo0 = S.row_info(cur, tid); if (has_next) rinfo = S.row_info(nxt, tid); }
        if constexpr (GATHER) {
            if (tid < 256) tab[tid] = rinfo0;
            asm volatile("s_waitcnt vmcnt(0) lgkmcnt(0)" ::: "memory"); __builtin_amdgcn_s_barrier(); asm volatile("" ::: "memory");
            PG8_GATHER_VO(cvo, tab);
        }
    }
    int tb = 0;
    PG8_STAGE(PG8_SA(0, 0), cA, cvo[0]); PG8_STAGE(PG8_SA(0, 1), cA, cvo[1]);
    if (wr == 1) PG8_BAR;
    PG8_WAIT_V(2); PG8_BAR;
    if constexpr (TABLE && !GATHER) { if (tid < 256) tab[tid] = rinfo0; }
    PG8_STAGE(PG8_SB(1, 0), cB + kstep, voffB[0]); PG8_STAGE(PG8_SA(1, 0), cA + kstep, cvo[0]); PG8_STAGE(PG8_SB(1, 1), cB + kstep, voffB[1]);
    PG8_WAIT_V(6); PG8_BAR;
    for (;;) {
        const char* nA = has_next ? S.a_ptr(nxt) : cA; const char* nB = has_next ? S.b_ptr(nxt) : cB;
        Unit nn; const bool has_nn = has_next && S.next(ui + 2, nn);
        if (peek != nullptr && !has_next && tid == 0) pk = __hip_atomic_load(peek, __ATOMIC_RELAXED, __HIP_MEMORY_SCOPE_AGENT);
        if constexpr (TABLE) {
            { int t2 = tid; asm volatile("" : "+v"(t2));
              if (has_next) { if (t2 < 256) tab[(tb == 2 ? 0 : tb + 1) * 256 + t2] = rinfo; }
              if (has_nn) { if (t2 < 256) rinfo = S.row_info(nn, t2); } }
        }
        for (int t = 0; t < nt; t += 2) {
            const bool last = (t == nt - 2);
            const bool fresh = (t == 0) && (ui > 0);
            const char* a1 = cA + (size_t)(t + 1) * kstep;
            const char* a2 = last ? nA : cA + (size_t)(t + 2) * kstep; const char* b2 = last ? nB : cB + (size_t)(t + 2) * kstep;
            const char* a3 = a2 + kstep; const char* b3 = b2 + kstep;
            unsigned vo2[2][2];
#pragma unroll
            for (int h = 0; h < 2; ++h)
#pragma unroll
                for (int i = 0; i < 2; ++i) vo2[h][i] = cvo[h][i];
            if constexpr (GATHER) { if (last && has_next) PG8_GATHER_VO(vo2, tab + (tb == 2 ? 0 : tb + 1) * 256); }
            PG8_LDB(B0, 0, 0); PG8_LDB(B1, 0, 1); PG8_SCHED; PG8_LDA(At, 0, 0); if (!fresh) PG8_STAGE(PG8_SA(1, 1), a1, cvo[1]);
            PG8_WAIT_VF(8); PG8_WAIT_L(0); PG8_BAR; PG8_MMA(0, 0, At, B0); PG8_MMA(0, 1, At, B1); PG8_BAR; PG8_SCHED;
            PG8_LDA(At, 0, 1); PG8_STAGE(PG8_SB(0, 0), b2, voffB[0]); PG8_STAGE(PG8_SB(0, 1), b2, voffB[1]); PG8_STAGE(PG8_SA(0, 0), a2, vo2[0]);
            PG8_WAIT_VF(14); PG8_WAIT_L(0); PG8_BAR; PG8_MMA(1, 0, At, B0); PG8_MMA(1, 1, At, B1); PG8_BAR; PG8_SCHED;
            PG8_LDB(B0, 1, 0); PG8_LDB(B1, 1, 1); PG8_SCHED; PG8_LDA(At, 1, 0); PG8_STAGE(PG8_SA(0, 1), a2, vo2[1]);
            PG8_WAIT_VF(10); PG8_WAIT_L(0); PG8_BAR; PG8_MMA(0, 0, At, B0); PG8_MMA(0, 1, At, B1); PG8_BAR; PG8_SCHED;
            PG8_LDA(At, 1, 1); PG8_STAGE(PG8_SB(1, 0), b3, voffB[0]); PG8_STAGE(PG8_SB(1, 1), b3, voffB[1]); PG8_STAGE(PG8_SA(1, 0), a3, vo2[0]);
            PG8_WAIT_VF(14); PG8_WAIT_L(0); PG8_BAR; PG8_MMA(1, 0, At, B0); PG8_MMA(1, 1, At, B1); PG8_BAR; PG8_SCHED;
            if (last) PG8_STAGE(PG8_SA(1, 1), a3, vo2[1]);
            if constexpr (Epi::MIDSCALE) {
                if ((t + 2) * BK == Epi::MIDK) {
#pragma unroll
                    for (int a = 0; a < 2; ++a)
#pragma unroll
                        for (int m = 0; m < 4; ++m) { const float rsc = __uint_as_float(tab[tb * 256 + a * 128 + wr * 64 + m * 16 + fr]);
#pragma unroll
                            for (int b = 0; b < 2; ++b)
#pragma unroll
                                for (int n = 0; n < 2; ++n) acc[a][b][m][n] *= rsc; }
                }
            }
        }
        if (wr == 0) PG8_BAR;
        { int fr_ = fr, fq_ = fq; asm volatile("" : "+v"(fr_), "+v"(fq_)); E(acc, cur, wr, wc, fr_, fq_, tab + tb * 256); }
        if (!has_next) break;
#pragma unroll
        for (int a = 0; a < 2; ++a)
#pragma unroll
            for (int b = 0; b < 2; ++b)
#pragma unroll
                for (int m = 0; m < 4; ++m)
#pragma unroll
                    for (int n = 0; n < 2; ++n) acc[a][b][m][n] = (f32x4){0.f, 0.f, 0.f, 0.f};
        cur = nxt; cA = nA; cB = nB; ++ui; tb = (tb == 2 ? 0 : tb + 1); nxt = nn; has_next = has_nn;
        if constexpr (GATHER) PG8_GATHER_VO(cvo, tab + tb * 256);
        if (wr == 1) PG8_BAR;
    }
    PG8_WAIT_V(0);
    PG8_BAR;
    return pk;
#undef PG8_GATHER_VO
#undef PG8_SA
#undef PG8_SB
#undef PG8_STAGE
#undef PG8_GLDS
#undef PG8_LDA
#undef PG8_LDB
#undef PG8_MMA
#undef PG8_WAIT_V
#undef PG8_WAIT_VF
#undef PG8_WAIT_L
#undef PG8_BAR
#undef PG8_SCHED
}
}

#define XB_TMO      128
#define XB_XCNT(j)  (256  + 64 * (j))
#define XB_XSUB(j)  (1280 + 64 * (j))
#define XB_XGEN(j)  (2304 + 64 * (j))
#define XB_TOP      3328
#define XB_TOPGEN   3392
#define XCD_BAR_WORDS 3456
#define XB_SPIN_CAP (1u << 18)
__device__ __forceinline__ unsigned xb_ld(unsigned* p)              { return __hip_atomic_load(p, __ATOMIC_RELAXED, __HIP_MEMORY_SCOPE_AGENT); }
__device__ __forceinline__ unsigned xb_add(unsigned* p, unsigned v) { return __hip_atomic_fetch_add(p, v, __ATOMIC_RELAXED, __HIP_MEMORY_SCOPE_AGENT); }
__device__ __forceinline__ unsigned xb_xcc_id() { return (unsigned)__builtin_amdgcn_s_getreg((3 << 11) | 20) & 0xFu; }
#define XB_SPIN(cond, bar) do { unsigned _sp = 0; while (cond) { __builtin_amdgcn_s_sleep(1); \
    if ((++_sp & 255u) == 0u) { if (xb_ld(&(bar)[XB_TMO])) break; if (_sp > XB_SPIN_CAP) { atomicAdd(&(bar)[XB_TMO], 1u); break; } } } } while (0)
struct XcdBarrier { unsigned* bar; unsigned x; volatile LAS unsigned* st; };
__device__ __forceinline__ XcdBarrier xcd_barrier_post(unsigned* bar, volatile LAS unsigned* st, int tid) {
    XcdBarrier b; b.bar = bar; b.x = xb_xcc_id(); b.st = st;
    if (tid == 0) (void)xb_add(&bar[XB_XCNT(b.x)], 1u);
    return b;
}
__device__ __forceinline__ void xcd_barrier_complete(unsigned* bar, unsigned x, unsigned& nloc, unsigned& nx) {
    const unsigned G = gridDim.x * gridDim.y * gridDim.z;
    unsigned sum, cnt, mine, sp = 0u;
    for (;;) {
        sum = 0u; cnt = 0u; mine = 0u;
#pragma unroll
        for (unsigned j = 0; j < 16; ++j) { const unsigned c = xb_ld(&bar[XB_XCNT(j)]); sum += c; cnt += (c > 0u) ? 1u : 0u; mine = (j == x) ? c : mine; }
        if (sum == G) break;
        __builtin_amdgcn_s_sleep(1);
        if ((++sp & 255u) == 0u) { if (xb_ld(&bar[XB_TMO])) break; if (sp > XB_SPIN_CAP) { atomicAdd(&bar[XB_TMO], 1u); break; } }
    }
    nloc = mine > 0u ? mine : 1u; nx = cnt > 0u ? cnt : 1u;
}
__device__ __forceinline__ void xcd_barrier(const XcdBarrier& b, int wave) {
    asm volatile("s_waitcnt vmcnt(0)" ::: "memory");
    __syncthreads();
    if (wave == 0 && lane_id() == 0) {
        unsigned* bar = b.bar;
        __builtin_amdgcn_s_waitcnt(0);
        unsigned nloc = b.st[0], nx = b.st[1];
        if (nloc == 0u) { xcd_barrier_complete(bar, b.x, nloc, nx); b.st[0] = nloc; b.st[1] = nx; }
        const unsigned old = xb_add(&bar[XB_XSUB(b.x)], 1u);
        const unsigned gen = old / nloc;
        if (old + 1u == (gen + 1u) * nloc) {
            __builtin_amdgcn_fence(__ATOMIC_RELEASE, "agent");
            asm volatile("s_waitcnt vmcnt(0)" ::: "memory");
            (void)xb_add(&bar[XB_TOP], 1u);
        }
        XB_SPIN(xb_ld(&bar[XB_TOP]) < (gen + 1u) * nx, bar);
        __builtin_amdgcn_fence(__ATOMIC_ACQUIRE, "agent");
        asm volatile("s_waitcnt vmcnt(0)" ::: "memory");
    }
    __syncthreads();
}

struct Args {
    const float* in[17]; float* out; unsigned char* ws; int ph_lo, ph_hi;
};
struct Frame {
    LAS unsigned char* lds; volatile LAS unsigned* MISC; unsigned* ctl;
    int tid, lane, wave, vcu, G, bx;
    unsigned char* ws;
};
constexpr int NWAVES = 8;
__device__ __forceinline__ void relaunder(Frame& F) {
    unsigned m = (unsigned)(uintptr_t)F.MISC, d = (unsigned)(uintptr_t)F.lds; asm volatile("" : "+s"(m), "+s"(d));
    F.MISC = (volatile LAS unsigned*)(uintptr_t)m; F.lds = (LAS unsigned char*)(uintptr_t)d;
    asm volatile("" : "+s"(F.wave), "+s"(F.vcu));
    F.bx = (int)blockIdx.x; asm volatile("" : "+s"(F.bx));
    F.lane = lane_id(); F.tid = F.wave * 64 + F.lane;
    asm volatile("" : "+v"(F.tid), "+v"(F.lane));
    unsigned long long w = (unsigned long long)(uintptr_t)F.ws; asm volatile("" : "+s"(w)); F.ws = (unsigned char*)(GAS unsigned char*)(uintptr_t)w;
}
__device__ __forceinline__ const float* in_ptr(const Frame& F, int i) {
    volatile LAS unsigned* p = F.MISC + 128 + 2 * i;
    const unsigned lo = __builtin_amdgcn_readfirstlane(p[0]), hi = __builtin_amdgcn_readfirstlane(p[1]);
    return (const float*)(const GAS float*)(uintptr_t)(((unsigned long long)hi << 32) | lo);
}

template <int WHICH>
struct DenseSched {
    unsigned char* ws; int l, G, c;
    static constexpr int nM = T / 256, nN = WHICH == 1 ? 5 : WHICH == 13 ? 9 : 4, pn0 = WHICH == 3 ? 5 : 0;
    __device__ __forceinline__ int total() const { return nM * nN; }
    __device__ __forceinline__ bool next(int i, pg8::Unit& u) const {
        int pm, pn; if (c >= G || !pg8::tile_order(i * G + c, nM, nN, pm, pn)) return false;
        u.pm = pm; u.pn = pn + pn0; u.e = 0; u.lt = 0; u.nvalid = 256; return true;
    }
    __device__ __forceinline__ const char* a_ptr(const pg8::Unit& u) const { return (const char*)(ws + (WHICH == 2 ? WS_Y : WS_XB)) + (size_t)u.pm * 256 * D * 2; }
    __device__ __forceinline__ const char* b_ptr(const pg8::Unit& u) const {
        return WHICH == 2 ? (const char*)(ws + WS_WOUT) + ((size_t)l * D + u.pn * 256) * D * 2 : (const char*)(ws + WS_WIN) + ((size_t)l * INW + u.pn * 256) * D * 2; }
    __device__ __forceinline__ unsigned row_info(const pg8::Unit& u, int r) const { return ((const unsigned*)(ws + (WHICH == 2 ? WS_RSA : WS_RSTD)))[u.pm * 256 + r]; }
};
template <bool UP>
struct MoeSched {
    unsigned char* ws; int l; volatile LAS unsigned* misc; int G, c;
    __device__ __forceinline__ int total() const { return (int)misc[16 + NE] * 4; }
    __device__ __forceinline__ bool next(int i, pg8::Unit& u) const {
        const int nM = __builtin_amdgcn_readfirstlane((int)misc[16 + NE]); int pm, pn; if (c >= G || !pg8::tile_order(i * G + c, nM, 4, pm, pn)) return false;
        int ln = lane_id(); asm volatile("" : "+v"(ln)); ln &= 31;
        const int e = __popcll(__ballot((int)misc[16 + ln] <= pm)) / (int)(64 / NE) - 1;
        u.pm = pm; u.pn = pn; u.e = e; u.lt = pm - __builtin_amdgcn_readfirstlane((int)misc[16 + e]); const int rem = __builtin_amdgcn_readfirstlane((int)misc[64 + e]) - u.lt * 256; u.nvalid = rem < 256 ? rem : 256;
        return true;
    }
    __device__ __forceinline__ const char* a_ptr(const pg8::Unit& u) const { return UP ? (const char*)(ws + WS_XB) : (const char*)(ws + WS_ACT) + (size_t)u.pm * 256 * DE * 2; }
    __device__ __forceinline__ const char* b_ptr(const pg8::Unit& u) const {
        return UP ? (const char*)(ws + WS_WGU) + ((size_t)(l * NE + u.e) * 1024 + u.pn * 256) * D * 2 : (const char*)(ws + WS_WDN) + ((size_t)(l * NE + u.e) * D + u.pn * 256) * DE * 2; }
    __device__ __forceinline__ unsigned row_info(const pg8::Unit& u, int r) const { return r < u.nvalid ? ((const unsigned*)(ws + WS_LISTS))[(size_t)u.e * LCAP + u.lt * 256 + r] : (UP ? 0u : 0xffffffffu); }
};

typedef f32x4 Acc[2][2][4][2];
__device__ __forceinline__ u32x4 pack8(const f32x4 a, const f32x4 b) { u32x4 w; w.x = cvt_pk_bf16(a[0], a[1]); w.y = cvt_pk_bf16(a[2], a[3]); w.z = cvt_pk_bf16(b[0], b[1]); w.w = cvt_pk_bf16(b[2], b[3]); return w; }

__device__ __forceinline__ u32x4 xchg8(const u32x4 v) { u32x4 r;
#pragma unroll
    for (int q = 0; q < 4; ++q) r[q] = (unsigned)__builtin_amdgcn_update_dpp(0, (int)v[q], 0x128, 0xf, 0xf, false);
    return r; }
__device__ __forceinline__ float xrow16(float v, bool odd) { auto rr = __builtin_amdgcn_permlane16_swap(__float_as_uint(v), __float_as_uint(v), false, false); return __uint_as_float(odd ? rr[0] : rr[1]); }
struct EpiProj { static constexpr bool MIDSCALE = false; static constexpr int NSTORE = 16;
    unsigned char* ws;
    __device__ __forceinline__ void operator()(const Acc& acc, const pg8::Unit& u, int wr, int wc, int fr, int fq, volatile LAS unsigned* tab) const {
        bf16_t* O = (bf16_t*)(ws + WS_PROJ); const float* cs = (const float*)(ws + WS_CS);
        const int row0 = u.pm * 256 + wr * 64 + fr;
        const int cw = u.pn * 256 + wc * 64;
        const bool rope_wave = cw < C_V;
        const bool ropel = rope_wave && fq < 2;
        const bool lo = fr < 8;
        const int colp = cw + (lo ? 0 : 32) + 8 * fq;
        f32x4 c[4][4];
#define EPROJ_LOADC(ai_, m_) do { if (ropel) { const f32x4* c4 = (const f32x4*)(cs + (size_t)((row0 + (ai_) * 128 + (m_) * 16) & (SEQ - 1)) * 16); \
            _Pragma("unroll") for (int q = 0; q < 4; ++q) c[m_][q] = c4[q]; } else { _Pragma("unroll") for (int q = 0; q < 4; ++q) c[m_][q] = (f32x4){1.f, 0.f, 1.f, 0.f}; } } while (0)
#pragma unroll
        for (int m = 0; m < 4; ++m) EPROJ_LOADC(0, m);
#pragma unroll
        for (int ai = 0; ai < 2; ++ai) {
            float r[4];
#pragma unroll
            for (int m = 0; m < 4; ++m) r[m] = __uint_as_float(tab[ai * 128 + wr * 64 + m * 16 + fr]);
#pragma unroll
            for (int m = 0; m < 4; ++m) {
                f32x4 v0 = acc[ai][0][m][0] * r[m], v1 = acc[ai][0][m][1] * r[m];
                if (rope_wave) {
                    f32x4 o0, o1;
#pragma unroll
                    for (int j = 0; j < 4; ++j) { o0[j] = xrow16(v0[j], (fq & 1) != 0); o1[j] = xrow16(v1[j], (fq & 1) != 0); }
                    const float sg = fq == 0 ? -1.f : 1.f;
                    v0[0] = v0[0] * c[m][0][0] + sg * o0[0] * c[m][0][1]; v0[1] = v0[1] * c[m][0][2] + sg * o0[1] * c[m][0][3];
                    v0[2] = v0[2] * c[m][1][0] + sg * o0[2] * c[m][1][1]; v0[3] = v0[3] * c[m][1][2] + sg * o0[3] * c[m][1][3];
                    v1[0] = v1[0] * c[m][2][0] + sg * o1[0] * c[m][2][1]; v1[1] = v1[1] * c[m][2][2] + sg * o1[1] * c[m][2][3];
                    v1[2] = v1[2] * c[m][3][0] + sg * o1[2] * c[m][3][1]; v1[3] = v1[3] * c[m][3][2] + sg * o1[3] * c[m][3][3];
                }
                if (ai == 0) EPROJ_LOADC(1, m);
                const u32x4 p0 = pack8(v0, v1), p1 = pack8(acc[ai][1][m][0] * r[m], acc[ai][1][m][1] * r[m]);
                const u32x4 rcv = xchg8(lo ? p1 : p0);
                bf16_t* rl = O + (size_t)(row0 + ai * 128 + m * 16 - (lo ? 0 : 8)) * PW + colp;
                *(u32x4*)rl = lo ? p0 : rcv;
                *(u32x4*)(rl + (size_t)8 * PW) = lo ? rcv : p1;
            }
        }
#undef EPROJ_LOADC
    }
};
struct EpiCu { static constexpr bool MIDSCALE = false; static constexpr int NSTORE = 8;
    unsigned char* ws;
    __device__ __forceinline__ void operator()(const Acc& acc, const pg8::Unit& u, int wr, int wc, int fr, int fq, volatile LAS unsigned* tab) const {
        bf16_t* O = (bf16_t*)(ws + WS_PROJ);
        const int row0 = u.pm * 256 + wr * 64 + fr;
        float r2[8];
#pragma unroll
        for (int i = 0; i < 8; ++i) { const float rs = __uint_as_float(tab[(i >> 2) * 128 + wr * 64 + (i & 3) * 16 + fr]); r2[i] = rs * rs; }
#pragma unroll
        for (int ai = 0; ai < 2; ++ai)
#pragma unroll
            for (int m = 0; m < 4; ++m) {
                const f32x4 p0 = acc[ai][0][m][0] * acc[ai][1][m][0] * r2[ai * 4 + m], p1 = acc[ai][0][m][1] * acc[ai][1][m][1] * r2[ai * 4 + m];
                *(u32x4*)(O + (size_t)(row0 + ai * 128 + m * 16) * PW + P_CU + (u.pn - 5) * 128 + wc * 32 + 8 * fq) = pack8(p0, p1);
            }
    }
};
struct EpiG1 { static constexpr bool MIDSCALE = false; static constexpr int NSTORE = 8;
    unsigned char* ws;
    __device__ __forceinline__ void operator()(const Acc& acc, const pg8::Unit& u, int wr, int wc, int fr, int fq, volatile LAS unsigned* tab) const {
        if (u.pn < 5) { EpiProj E{ws}; E(acc, u, wr, wc, fr, fq, tab); } else { EpiCu E{ws}; E(acc, u, wr, wc, fr, fq, tab); }
    }
};
struct EpiResid { static constexpr bool MIDSCALE = true; static constexpr int MIDK = AW; static constexpr int NSTORE = 24;
    unsigned char* ws;
    __device__ __forceinline__ void operator()(const Acc& acc, const pg8::Unit& u, int wr, int wc, int fr, int fq, volatile LAS unsigned* tab) const {
        bf16_t* XB = (bf16_t*)(ws + WS_XB); float* SS = (float*)(ws + WS_SS);
        const int row0 = u.pm * 256 + wr * 64 + fr;
        const bool lo = fr < 8;
        const int colp = u.pn * 256 + wc * 64 + (lo ? 0 : 32) + 8 * fq;
        u32x4 xa[2][4], xb2[2][4];
#pragma unroll
        for (int ai = 0; ai < 2; ++ai)
#pragma unroll
            for (int m = 0; m < 4; ++m) { const bf16_t* rl = XB + (size_t)(row0 + ai * 128 + m * 16 - (lo ? 0 : 8)) * D + colp; xa[ai][m] = *(const u32x4*)rl; xb2[ai][m] = *(const u32x4*)(rl + (size_t)8 * D); }
#pragma unroll
        for (int ai = 0; ai < 2; ++ai) {
#pragma unroll
            for (int m = 0; m < 4; ++m) {
                const int row = row0 + ai * 128 + m * 16;
                const u32x4 r0 = xchg8(xa[ai][m]), r1 = xchg8(xb2[ai][m]);
                const u32x4 x0 = lo ? xa[ai][m] : r1, x1 = lo ? r0 : xb2[ai][m];
                f32x4 v00 = acc[ai][0][m][0], v01 = acc[ai][0][m][1], v10 = acc[ai][1][m][0], v11 = acc[ai][1][m][1];
                v00[0] += bflo(x0.x); v00[1] += bfhi(x0.x); v00[2] += bflo(x0.y); v00[3] += bfhi(x0.y); v01[0] += bflo(x0.z); v01[1] += bfhi(x0.z); v01[2] += bflo(x0.w); v01[3] += bfhi(x0.w);
                v10[0] += bflo(x1.x); v10[1] += bfhi(x1.x); v10[2] += bflo(x1.y); v10[3] += bfhi(x1.y); v11[0] += bflo(x1.z); v11[1] += bfhi(x1.z); v11[2] += bflo(x1.w); v11[3] += bfhi(x1.w);
                float sq = 0.f;
#pragma unroll
                for (int j = 0; j < 4; ++j) sq += v00[j] * v00[j] + v01[j] * v01[j] + v10[j] * v10[j] + v11[j] * v11[j];
                sq += __shfl_xor(sq, 16); sq += __shfl_xor(sq, 32);
                if (fq == 0) SS[(size_t)(u.pn * 4 + wc) * T + row] = sq;
                const u32x4 p0 = pack8(v00, v01), p1 = pack8(v10, v11);
                const u32x4 rcv = xchg8(lo ? p1 : p0);
                bf16_t* rl = XB + (size_t)(row - (lo ? 0 : 8)) * D + colp;
                *(u32x4*)rl = lo ? p0 : rcv;
                *(u32x4*)(rl + (size_t)8 * D) = lo ? rcv : p1;
            }
        }
    }
};
struct EpiAct { static constexpr bool MIDSCALE = false; static constexpr int NSTORE = 8;
    MoeSched<true> S;
    __device__ __forceinline__ void operator()(const Acc& acc, const pg8::Unit& u, int wr, int wc, int fr, int fq, volatile LAS unsigned* tab) const {
        bf16_t* ACT = (bf16_t*)(S.ws + WS_ACT);
#pragma unroll
        for (int ai = 0; ai < 2; ++ai)
#pragma unroll
            for (int m = 0; m < 4; ++m) {
                const int r = ai * 128 + wr * 64 + m * 16 + fr; const float rs = __uint_as_float(tab[r] & 0xffff0000u);
                f32x4 o[2];
#pragma unroll
                for (int n = 0; n < 2; ++n)
#pragma unroll
                    for (int j = 0; j < 4; ++j) { const float g = acc[ai][0][m][n][j] * rs, up = acc[ai][1][m][n][j] * rs; o[n][j] = g * __builtin_amdgcn_rcpf(1.0f + __builtin_amdgcn_exp2f(-g * LOG2E)) * up; }
                *(u32x4*)(ACT + (size_t)(u.pm * 256 + r) * DE + u.pn * 128 + wc * 32 + 8 * fq) = pack8(o[0], o[1]);
            }
    }
};
struct EpiDown { static constexpr bool MIDSCALE = false; static constexpr int NSTORE = 16;
    MoeSched<false> S;
    __device__ __forceinline__ void operator()(const Acc& acc, const pg8::Unit& u, int wr, int wc, int fr, int fq, volatile LAS unsigned* tab) const {
        unsigned char* YK = S.ws + WS_YK;
        const bool lo = fr < 8;
        const unsigned colb = (unsigned)(u.pn * 256 + wc * 64 + (lo ? 0 : 32) + 8 * fq) * 2u;
#pragma unroll
        for (int ai = 0; ai < 2; ++ai)
#pragma unroll
            for (int m = 0; m < 4; ++m) {
                const unsigned q1 = tab[ai * 128 + wr * 64 + m * 16 + (fr & 7)], q2 = tab[ai * 128 + wr * 64 + m * 16 + 8 + (fr & 7)];
                const unsigned o1 = (q1 == 0xffffffffu ? (unsigned)(2 * T) : (q1 & 0xffffu)) * (unsigned)(D * 2) + colb, o2 = (q2 == 0xffffffffu ? (unsigned)(2 * T) : (q2 & 0xffffu)) * (unsigned)(D * 2) + colb;
                const u32x4 p0 = pack8(acc[ai][0][m][0], acc[ai][0][m][1]), p1 = pack8(acc[ai][1][m][0], acc[ai][1][m][1]);
                const u32x4 r0 = xchg8(p0), r1 = xchg8(p1);
                *(u32x4*)(YK + o1) = lo ? p0 : r1;
                *(u32x4*)(YK + o2) = lo ? r0 : p1;
                __builtin_amdgcn_sched_barrier(0);
            }
    }
};

__device__ __forceinline__ void p0_tile(const float* W, int ldw, int k0, int n0, bf16_t* WT, int Kt, int dst_row0, const float* gk, float cs, LAS unsigned char* scr, int lane, bool split = false) {
    const int r0 = lane >> 4, c = lane & 15;
    const float* src = W + (size_t)(k0 + 16 * r0) * ldw + n0 + 4 * c;
    f32x4 v[16];
#pragma unroll
    for (int i = 0; i < 16; ++i) v[i] = __builtin_nontemporal_load((const f32x4*)(src + (size_t)i * ldw));
    float g[16];
    if (gk) {
#pragma unroll
        for (int q = 0; q < 4; ++q) { const f32x4 t = *(const f32x4*)(gk + k0 + 16 * r0 + 4 * q); g[4 * q] = t[0] * cs; g[4 * q + 1] = t[1] * cs; g[4 * q + 2] = t[2] * cs; g[4 * q + 3] = t[3] * cs; }
    } else {
#pragma unroll
        for (int i = 0; i < 16; ++i) g[i] = cs;
    }
#pragma unroll
    for (int j = 0; j < 4; ++j) {
        u32x4 lo, hi2;
        lo.x = cvt_pk_bf16(v[0][j] * g[0], v[1][j] * g[1]); lo.y = cvt_pk_bf16(v[2][j] * g[2], v[3][j] * g[3]); lo.z = cvt_pk_bf16(v[4][j] * g[4], v[5][j] * g[5]); lo.w = cvt_pk_bf16(v[6][j] * g[6], v[7][j] * g[7]);
        hi2.x = cvt_pk_bf16(v[8][j] * g[8], v[9][j] * g[9]); hi2.y = cvt_pk_bf16(v[10][j] * g[10], v[11][j] * g[11]); hi2.z = cvt_pk_bf16(v[12][j] * g[12], v[13][j] * g[13]); hi2.w = cvt_pk_bf16(v[14][j] * g[14], v[15][j] * g[15]);
        const int n = 4 * c + j, sw = c & 7;
        *(LAS u32x4*)(scr + n * 128 + (((2 * r0) ^ sw) << 4)) = lo;
        *(LAS u32x4*)(scr + n * 128 + (((2 * r0 + 1) ^ sw) << 4)) = hi2;
    }
    LDS_WAIT(); asm volatile("" ::: "memory");
    const int ch = lane & 7;
#pragma unroll
    for (int i = 0; i < 8; ++i) { const int n = 8 * i + (lane >> 3);
        const u32x4 o = *(const LAS u32x4*)(scr + n * 128 + ((ch ^ ((n >> 2) & 7)) << 4));
        *(u32x4*)(WT + (size_t)(dst_row0 + n + (split ? 32 * (n >> 5) : 0)) * Kt + k0 + 8 * ch) = o; }
    LDS_WAIT(); asm volatile("" ::: "memory");
}
constexpr int CV_IN = 16 * 36, CV_OUT = 16 * 16, CV_G = NE * 128, CV_U = NE * 128, CV_D = NE * 128, CV_L = CV_IN + CV_OUT + CV_G + CV_U + CV_D;
__device__ __forceinline__ void convert_item(Frame& F, int l, int r, LAS unsigned char* scr) {
    unsigned char* ws = F.ws;
    if (r < CV_IN) { const int kb = r / 36, nb = r % 36;
        const int n0 = nb * 64;
        const int jc = n0 - C_C, ju = n0 - C_U;
        const int dst = n0 < C_C ? n0 : (n0 < C_U ? C_C + 256 * (jc / 128) + 2 * (jc % 128) : C_C + 256 * (ju / 128) + 2 * (ju % 128) + 32);
        p0_tile(in_ptr(F, 2) + (size_t)l * D * INW, INW, kb * 64, n0, (bf16_t*)(ws + WS_WIN) + (size_t)l * INW * D, D, dst, in_ptr(F, 1) + l * D, (n0 < C_K) ? QSCALE : 1.0f, scr, F.lane, n0 >= C_C); return; }
    r -= CV_IN;
    if (r < CV_OUT) { const int kb = r / 16, nb = r % 16; const int k0 = kb * 64;
        const float* gk = (k0 < AW) ? in_ptr(F, 5) + l * AW : in_ptr(F, 6) + l * CW - AW;
        p0_tile(in_ptr(F, 7) + (size_t)l * D * D, D, k0, nb * 64, (bf16_t*)(ws + WS_WOUT) + (size_t)l * D * D, D, nb * 64, gk, 1.0f, scr, F.lane); return; }
    r -= CV_OUT;
    if (r < CV_G + CV_U) { const int up = r >= CV_G; if (up) r -= CV_G; const int e = r / 128, q = r % 128, kb = q / 8, nb = q % 8; const int n0 = nb * 64;
        const float* W = in_ptr(F, up ? 14 : 13) + ((size_t)l * NE + e) * D * DE;
        p0_tile(W, DE, kb * 64, n0, (bf16_t*)(ws + WS_WGU) + ((size_t)l * NE + e) * 1024 * D, D, 256 * (n0 / 128) + 2 * (n0 % 128) + (up ? 32 : 0), in_ptr(F, 8) + l * D, 1.0f, scr, F.lane, true); return; }
    r -= CV_G + CV_U;
    { const int e = r / 128, q = r % 128, kb = q / 16, nb = q % 16;
      p0_tile(in_ptr(F, 15) + ((size_t)l * NE + e) * DE * D, D, kb * 64, nb * 64, (bf16_t*)(ws + WS_WDN) + ((size_t)l * NE + e) * D * DE, DE, nb * 64, nullptr, 1.0f, scr, F.lane); }
}
#ifndef CVX
#define CVX 4424
#define CVY 1344
#endif
#ifndef CV0
#define CV0 CVX
#endif
constexpr int CV_TOT = DEPTH * CV_L, CV_GUEND = CV_IN + CV_OUT + CV_G + CV_U;
static_assert(CVX >= CV_IN + CV_OUT && CVX <= CV_GUEND && CVY >= 0 && CVY <= CVX && CV0 >= CV_IN + CV_OUT && CV0 <= CV_GUEND, "conversion schedule");
__device__ __forceinline__ int cv_end(int l, int ph) { const int e = ph == 0 ? l * CV_L + CV_GUEND : ph == 1 ? (l + 1) * CV_L + CVY : (l + 1) * CV_L + CVX; return e < CV_TOT ? e : CV_TOT; }
__device__ __forceinline__ int cv_start(int l, int ph) { return ph == 0 ? (l == 0 ? CV0 : cv_end(l - 1, 2)) : cv_end(l, ph - 1); }
__device__ __forceinline__ int gemm_cus(int U, int G) { const int mx = (U + G - 1) / G; const int n = ((U + mx - 1) / mx + 7) & ~7; return n < G ? n : G; }
__device__ __forceinline__ void convert_work(Frame& F, unsigned* ctr, int start, int end, bool conv_cu, unsigned pk) {
    if (start >= end) return;
    const unsigned n = (unsigned)(end - start);
    volatile LAS unsigned* mb = F.MISC + 8;
    LAS unsigned char* scr = F.lds + F.wave * 16384;
    unsigned nxt = 0xffffffffu;
    if (F.tid == 0 && (conv_cu || pk < n)) nxt = __hip_atomic_fetch_add(ctr, 8u, __ATOMIC_RELAXED, __HIP_MEMORY_SCOPE_AGENT);
    for (;;) {
        if (F.tid == 0) mb[0] = nxt;
        __syncthreads();
        const unsigned base = mb[0];
        if (base >= n) break;
        if (F.tid == 0) nxt = __hip_atomic_fetch_add(ctr, 8u, __ATOMIC_RELAXED, __HIP_MEMORY_SCOPE_AGENT);
        const int it = start + (int)base + F.wave;
        if (it < end) convert_item(F, it / CV_L, it % CV_L, scr);
        __syncthreads();
    }
}
__device__ __forceinline__ void phase_prologue(Frame& F) {
    LAS unsigned char* scr = F.lds + F.wave * 16384;
    const int gw = F.vcu * NWAVES + F.wave, NGW = F.G * NWAVES;
    unsigned char* ws = F.ws;
    for (int it = gw; it < CV0; it += NGW) convert_item(F, it / CV_L, it % CV_L, scr);
    relaunder(F);
    {
        const int gt0 = F.vcu * 512 + F.tid, NGT0 = F.G * 512;
        for (int i = gt0; i < DEPTH * NE * D; i += NGT0) {
            const int l = i / (NE * D), e = (i / D) % NE, k = i % D;
            const float v = in_ptr(F, 11)[(size_t)l * D * NE + k * NE + e] * in_ptr(F, 8)[l * D + k];
            ((bf16_t*)(ws + WS_WR))[(size_t)l * 64 * D + (size_t)e * D + k] = (bf16_t)(cvt_pk_bf16(v, 0.f) & 0xffffu);
        }
    }
    const int gt = F.vcu * 512 + F.tid, NGT = F.G * 512;
    for (int i = gt; i < DEPTH * 32 * D; i += NGT) {
        const int l = i / (32 * D), rr = (i / D) % 32, k = i % D;
        float v = 0.f; if (rr < NG) v = in_ptr(F, 9)[(size_t)l * D * NG + k * NG + rr] * in_ptr(F, 8)[l * D + k];
        ((bf16_t*)(ws + WS_WR))[(size_t)l * 64 * D + (size_t)(32 + rr) * D + k] = (bf16_t)(cvt_pk_bf16(v, 0.f) & 0xffffu);
    }
    for (int i = gt; i < SEQ * 8; i += NGT) {
        const int pos = i >> 3, f = i & 7;
        const double ang = (double)pos * pow(500000.0, -(double)f / 8.0);
        ((float2*)(ws + WS_CS))[i] = make_float2((float)cos(ang), (float)sin(ang));
    }
    relaunder(F);
    const float* x = in_ptr(F, 0);
    for (int row = gw; row < T; row += NGW) {
        const f32x4* xr = (const f32x4*)(x + (size_t)row * D) + F.lane;
        f32x4 v[4]; float s = 0.f;
#pragma unroll
        for (int j = 0; j < 4; ++j) { v[j] = xr[64 * j]; s += v[j][0] * v[j][0] + v[j][1] * v[j][1] + v[j][2] * v[j][2] + v[j][3] * v[j][3]; }
        s = wave_sum(s);
        if (F.lane == 0) ((float*)(ws + WS_RSTD))[row] = rsqrtf(s * (1.0f / D) + EPS);
        u32x2* o = (u32x2*)((bf16_t*)(ws + WS_XB) + (size_t)row * D) + F.lane;
#pragma unroll
        for (int j = 0; j < 4; ++j) { u32x2 w; w.x = cvt_pk_bf16(v[j][0], v[j][1]); w.y = cvt_pk_bf16(v[j][2], v[j][3]); o[64 * j] = w; }
    }
}

typedef float f32x16 __attribute__((ext_vector_type(16)));
typedef short v4i16 __attribute__((ext_vector_type(4)));
constexpr int ATT_K_OFF = 0, ATT_V_OFF = 49152, ATT_STG_OFF = 98304;
constexpr int SSQ_WORD = 1024, RSQ_WORD = 2048;
__device__ __forceinline__ int crow(int r, int hi) { return (r & 3) + 8 * (r >> 2) + 4 * hi; }

__device__ __forceinline__ float xhalf_max(float v) { auto rr = __builtin_amdgcn_permlane32_swap(__float_as_uint(v), __float_as_uint(v), false, false); return fmaxf(__uint_as_float(rr[0]), __uint_as_float(rr[1])); }
__device__ __forceinline__ float xhalf_sum(float v) { auto rr = __builtin_amdgcn_permlane32_swap(__float_as_uint(v), __float_as_uint(v), false, false); return __uint_as_float(rr[0]) + __uint_as_float(rr[1]); }
template <int MASK>
__device__ __forceinline__ void attn_step(LAS unsigned char* lds, int kt, const bf16x8 (&qf)[4], const unsigned (&koff)[4], const unsigned (&vb)[2], int ql, int hi, float& m, float& l, f32x16 (&o)[2], f32x16& negm) {
    const LAS unsigned char* kb = lds + ATT_K_OFF + kt * 4096;
    const LAS unsigned char* vbase = lds + ATT_V_OFF + kt * 4096;
    bf16x8 kf[4];
#pragma unroll
    for (int ks = 0; ks < 4; ++ks) kf[ks] = *(const LAS bf16x8*)(kb + koff[ks]);
    f32x16 sacc = __builtin_amdgcn_mfma_f32_32x32x16_bf16(kf[0], qf[0], negm, 0, 0, 0);
#pragma unroll
    for (int ks = 1; ks < 4; ++ks) sacc = __builtin_amdgcn_mfma_f32_32x32x16_bf16(kf[ks], qf[ks], sacc, 0, 0, 0);
    v4i16 va[4], vc[4];
#pragma unroll
    for (int i = 0; i < 4; ++i) {
        va[i] = __builtin_amdgcn_ds_read_tr16_b64_v4i16((LAS v4i16*)(vbase + vb[i >> 1] + (i & 1) * 2048));
        vc[i] = __builtin_amdgcn_ds_read_tr16_b64_v4i16((LAS v4i16*)(vbase + vb[i >> 1] + (i & 1) * 2048 + 1024));
    }
    if (MASK == 1) {
#pragma unroll
        for (int r = 0; r < 16; ++r) if (crow(r, hi) < ql) sacc[r] = -1e30f;
    }
    if (MASK == 2) {
#pragma unroll
        for (int r = 0; r < 16; ++r) if (crow(r, hi) > ql) sacc[r] = -1e30f;
    }
    float mx = sacc[0];
#pragma unroll
    for (int r = 1; r < 16; ++r) mx = fmaxf(mx, sacc[r]);
    mx = xhalf_max(mx);
    if (!__all(mx <= 8.0f)) {
        asm volatile("" ::: "memory");
        const float d = fmaxf(mx, 0.f), alpha = __builtin_amdgcn_exp2f(-d);
        l *= alpha;
#pragma unroll
        for (int r = 0; r < 16; ++r) { o[0][r] *= alpha; o[1][r] *= alpha; sacc[r] -= d; negm[r] -= d; }
        m += d;
    }
    float ps = 0.f;
#pragma unroll
    for (int r = 0; r < 16; ++r) { sacc[r] = __builtin_amdgcn_exp2f(sacc[r]); ps += sacc[r]; }
    l += ps;
    bf16x8 pf[2];
#pragma unroll
    for (int s2 = 0; s2 < 2; ++s2) {
        u32x4 w; w.x = cvt_pk_bf16(sacc[8 * s2 + 0], sacc[8 * s2 + 1]); w.y = cvt_pk_bf16(sacc[8 * s2 + 2], sacc[8 * s2 + 3]); w.z = cvt_pk_bf16(sacc[8 * s2 + 4], sacc[8 * s2 + 5]); w.w = cvt_pk_bf16(sacc[8 * s2 + 6], sacc[8 * s2 + 7]);
        pf[s2] = __builtin_bit_cast(bf16x8, w);
    }
#pragma unroll
    for (int i = 0; i < 4; ++i) {
        const bf16x8 vf = (bf16x8){va[i][0], va[i][1], va[i][2], va[i][3], vc[i][0], vc[i][1], vc[i][2], vc[i][3]};
        o[i >> 1] = __builtin_amdgcn_mfma_f32_32x32x16_bf16(vf, pf[i & 1], o[i >> 1], 0, 0, 0);
    }
}

__device__ __forceinline__ void phase_mixer(Frame& F, const float* sink, const float* cw) {
    const bf16_t* P = (const bf16_t*)(F.ws + WS_PROJ);
    bf16_t* Y = (bf16_t*)(F.ws + WS_Y);
    const int tid = F.tid, lane = F.lane, w = F.wave;
    const int ql = lane & 31, hi = lane >> 5;
    LAS unsigned char* lds = F.lds;
    volatile LAS float* ssq = (volatile LAS float*)(F.MISC + SSQ_WORD);
    volatile LAS float* rsq = (volatile LAS float*)(F.MISC + RSQ_WORD);
    unsigned koff[4], vb[2];
#pragma unroll
    for (int ks = 0; ks < 4; ++ks) koff[ks] = (unsigned)(ql * 128 + (((2 * ks + hi) ^ ((ql >> 1) & 7)) << 4));
    { const int g = (lane >> 4) & 1, li = lane & 15, q = li >> 2, p = li & 3, sw = (q >> 1) & 1;
      vb[0] = (unsigned)((4 * hi + q) * 128 + 64 * sw + 32 * g + 8 * p); vb[1] = (unsigned)((4 * hi + q) * 128 + 64 * (1 - sw) + 32 * g + 8 * p); }
    for (int unit = F.vcu; unit < BATCH * (SEQ / 128); unit += F.G) {
        const int b = unit / (SEQ / 128), n = unit % (SEQ / 128);
        const size_t tok0 = (size_t)b * SEQ + (size_t)n * 128;
#pragma unroll 1
        for (int part = 0; part < 2; ++part) {
        if ((part == 0) != ((F.vcu & 1) != 0)) {
        u32x4 kv[6], vv[6];
#define ATT_LOAD_K(kvh_) do { _Pragma("unroll") for (int i = 0; i < 6; ++i) { const int idx = tid + 512 * i, key = idx >> 3, ch = idx & 7; \
            const int kpos = (n - 1) * 128 + key; const int kc = kpos < 0 ? 0 : (kpos >= SEQ ? SEQ - 1 : kpos); \
            kv[i] = *(const u32x4*)(P + ((size_t)b * SEQ + kc) * PW + (kvh_) * HD + ch * 8 + C_K); } } while (0)
#define ATT_LOAD_V(kvh_) do { _Pragma("unroll") for (int i = 0; i < 6; ++i) { const int idx = tid + 512 * i, key = idx >> 3, ch = idx & 7; \
            const int kpos = (n - 1) * 128 + key; const int kc = kpos < 0 ? 0 : (kpos >= SEQ ? SEQ - 1 : kpos); \
            vv[i] = *(const u32x4*)(P + ((size_t)b * SEQ + kc) * PW + (kvh_) * HD + ch * 8 + C_V); } } while (0)
        { int tid = F.tid; asm volatile("" : "+v"(tid)); ATT_LOAD_K(0); ATT_LOAD_V(0); }
#pragma unroll
        for (int kvh = 0; kvh < 2; ++kvh) {
            int tid = F.tid; asm volatile("" : "+v"(tid));
            if (kvh == 1) ATT_LOAD_V(1);
            __syncthreads();
            const int head = kvh * 4 + (w >> 1), qh = w & 1;
#pragma unroll
            for (int i = 0; i < 6; ++i) {
                const int idx = tid + 512 * i, key = idx >> 3, ch = idx & 7;
                const int kpos = (n - 1) * 128 + key; const bool ok = kpos >= 0 && kpos < SEQ;
                const u32x4 z = (u32x4){0u, 0u, 0u, 0u};
                *(LAS u32x4*)(lds + ATT_K_OFF + key * 128 + ((ch ^ ((key >> 1) & 7)) << 4)) = ok ? kv[i] : z;
                *(LAS u32x4*)(lds + ATT_V_OFF + key * 128 + ((ch ^ (((key >> 1) & 1) << 2)) << 4)) = ok ? vv[i] : z;
            }
            if (kvh == 0) ATT_LOAD_K(1);
            __syncthreads();
            const float sk = sink[head] * LOG2E;
#pragma unroll
            for (int qt = 0; qt < 2; ++qt) {
                int lane_q = lane; asm volatile("" : "+v"(lane_q)); const int ql = lane_q & 31, hi = lane_q >> 5;
                const int q0 = 64 * qh + 32 * qt;
                const bf16_t* qrow = P + (tok0 + q0 + ql) * PW + C_Q + head * HD + 8 * hi;
                bf16x8 qf[4];
#pragma unroll
                for (int ks = 0; ks < 4; ++ks) qf[ks] = *(const bf16x8*)(qrow + 16 * ks);
                float m = sk, l = hi == 0 ? 1.f : 0.f;
                f32x16 negm;
#pragma unroll
                for (int r = 0; r < 16; ++r) negm[r] = -sk;
                f32x16 o[2];
#pragma unroll
                for (int r = 0; r < 16; ++r) { o[0][r] = 0.f; o[1][r] = 0.f; }
                const int kt0 = q0 >> 5;
                if (n - 1 + (kt0 >> 2) >= 0) attn_step<1>(lds, kt0, qf, koff, vb, ql, hi, m, l, o, negm);
#pragma unroll 1
                for (int j = 1; j < 8; ++j) { const int kt = kt0 + j; const int gb = n - 1 + (kt >> 2); if (gb >= 0 && gb < SEQ / 128) attn_step<0>(lds, kt, qf, koff, vb, ql, hi, m, l, o, negm); }
                if (n - 1 + ((kt0 + 8) >> 2) < SEQ / 128) attn_step<2>(lds, kt0 + 8, qf, koff, vb, ql, hi, m, l, o, negm);
                const float lt = xhalf_sum(l);
                const float inv = 1.0f / lt;
                float sq = 0.f;
#pragma unroll
                for (int dt = 0; dt < 2; ++dt)
#pragma unroll
                    for (int r = 0; r < 16; ++r) { o[dt][r] *= inv; sq += o[dt][r] * o[dt][r]; }
                sq = xhalf_sum(sq);
                if (hi == 0) ssq[head * 128 + q0 + ql] = sq;
                {   LAS unsigned char* stg = lds + ATT_STG_OFF + w * 4096;
#pragma unroll
                    for (int dt = 0; dt < 2; ++dt)
#pragma unroll
                        for (int g = 0; g < 4; ++g) {
                            const int c8 = 4 * dt + g;
                            u32x2 wv; wv.x = cvt_pk_bf16(o[dt][4 * g], o[dt][4 * g + 1]); wv.y = cvt_pk_bf16(o[dt][4 * g + 2], o[dt][4 * g + 3]);
                            *(LAS u32x2*)(stg + ql * 128 + ((c8 ^ (ql & 7)) << 4) + 8 * hi) = wv; }
                    asm volatile("s_waitcnt lgkmcnt(0)" ::: "memory");
#pragma unroll
                    for (int i = 0; i < 4; ++i) { const int row = 8 * i + (lane_q >> 3), ch = lane_q & 7;
                        const u32x4 v = *(const LAS u32x4*)(stg + row * 128 + ((ch ^ (row & 7)) << 4));
                        *(u32x4*)(Y + (tok0 + q0 + row) * D + head * HD + 8 * ch) = v; }
                    asm volatile("s_waitcnt lgkmcnt(0)" ::: "memory");
                }
            }
        }
        __syncthreads();
        if (tid < 128) { float s = 0.f;
#pragma unroll
            for (int h = 0; h < 8; ++h) s += ssq[h * 128 + tid];
            ((float*)(F.ws + WS_RSA))[tok0 + tid] = rsqrtf(s * (1.0f / AW) + EPS); }
        } else
        {
            int lane_c = lane; asm volatile("" : "+v"(lane_c));
            float cwv[3][8];
#pragma unroll
            for (int k = 0; k < 3; ++k) { const f32x4 a = *(const f32x4*)(cw + k * CW + 8 * lane_c), b2 = *(const f32x4*)(cw + k * CW + 8 * lane_c + 4);
#pragma unroll
                for (int jj = 0; jj < 4; ++jj) { cwv[k][jj] = a[jj]; cwv[k][4 + jj] = b2[jj]; } }
#pragma unroll 1
            for (int bt = 0; bt < 2; ++bt) {
                const int p0 = n * 128 + 16 * w + 8 * bt;
                const bf16_t* pr0 = P + (tok0 + 16 * w + 8 * bt) * PW;
                const u32x4 zero = (u32x4){0u, 0u, 0u, 0u};
                u32x4 cc[10], bb[8];
#pragma unroll
                for (int r = 0; r < 10; ++r) { const int pos = p0 - 1 + r; const bool ok = pos >= 0 && pos < SEQ;
                    cc[r] = ok ? *(const u32x4*)(pr0 + (ptrdiff_t)(r - 1) * PW + P_CU + 8 * lane_c) : zero; }
#pragma unroll
                for (int r = 0; r < 8; ++r) bb[r] = *(const u32x4*)(pr0 + (size_t)r * PW + C_B + 8 * lane_c);
                float cu[10][8];
#pragma unroll
                for (int r = 0; r < 10; ++r)
#pragma unroll
                    for (int wi = 0; wi < 4; ++wi) { cu[r][2 * wi] = bflo(cc[r][wi]); cu[r][2 * wi + 1] = bfhi(cc[r][wi]); }
#pragma unroll
                for (int r = 0; r < 8; ++r) {
                    float yc[8]; float s2 = 0.f;
#pragma unroll
                    for (int jj = 0; jj < 8; ++jj) {
                        const float gb = (jj & 1) ? bfhi(bb[r][jj >> 1]) : bflo(bb[r][jj >> 1]);
                        yc[jj] = gb * (cwv[0][jj] * cu[r][jj] + cwv[1][jj] * cu[r + 1][jj] + cwv[2][jj] * cu[r + 2][jj]); s2 += yc[jj] * yc[jj];
                    }
                    s2 = wave_sum(s2);
                    const float rstd = rsqrtf(s2 * (1.0f / CW) + EPS);
                    u32x4 wv; wv.x = cvt_pk_bf16(yc[0] * rstd, yc[1] * rstd); wv.y = cvt_pk_bf16(yc[2] * rstd, yc[3] * rstd); wv.z = cvt_pk_bf16(yc[4] * rstd, yc[5] * rstd); wv.w = cvt_pk_bf16(yc[6] * rstd, yc[7] * rstd);
                    *(u32x4*)(Y + (tok0 + 16 * w + 8 * bt + r) * D + AW + 8 * lane_c) = wv;
                }
            }
        }
        }
    }
}


constexpr int RT_PITCH = 2064;
constexpr int LCNT_WORD = 2304, GBASE_WORD = 2368;
__device__ __forceinline__ void router_stage(Frame& F, int l) {
    const bf16_t* WR = (const bf16_t*)(F.ws + WS_WR) + (size_t)l * 64 * D;
    const int tid = F.tid; LAS unsigned char* lds = F.lds;
    __syncthreads();
    u32x4 wv[9];
#pragma unroll
    for (int j = 0; j < 9; ++j) { const int i = tid + 512 * j; wv[j] = *(const u32x4*)(WR + (size_t)(i >> 7) * D + (i & 127) * 8); }
#pragma unroll
    for (int j = 0; j < 9; ++j) { const int i = tid + 512 * j; *(LAS u32x4*)(lds + (i >> 7) * RT_PITCH + (i & 127) * 16) = wv[j]; }
}
__device__ __forceinline__ void phase_router(Frame& F, int l, const float* brg, const float* bre) {
    const bf16_t* XB = (const bf16_t*)(F.ws + WS_XB);
    const float* SS = (const float*)(F.ws + WS_SS);
    float* RSTD = (float*)(F.ws + WS_RSTD); float* GATES = (float*)(F.ws + WS_GATES); int* LISTS = (int*)(F.ws + WS_LISTS);
    unsigned* cnt = F.ctl + CW_CNT + l * NE * 64;
    const int tid = F.tid, lane = F.lane, w = F.wave, ql = lane & 31, hi = lane >> 5;
    LAS unsigned char* lds = F.lds;
    volatile LAS unsigned* lcnt = F.MISC + LCNT_WORD; volatile LAS unsigned* gbase = F.MISC + GBASE_WORD;
    if (tid < NE) lcnt[tid] = 0u;
    __syncthreads();
    for (int unit = F.vcu; unit < T / 128; unit += F.G) {
        int e0 = 0, e1 = 0; unsigned rank0 = 0, rank1 = 0; float g0 = 0.f, g1 = 0.f, rstd = 0.f;
        const int t = unit * 128 + 32 * w + ql;
        if (w < 4) {
            f32x16 acc0, acc1;
#pragma unroll
            for (int r = 0; r < 16; ++r) { acc0[r] = 0.f; acc1[r] = 0.f; }
            const bf16_t* xr = XB + (size_t)t * D + 32 * hi;
            const LAS unsigned char* a0p = lds + ql * RT_PITCH + 64 * hi;
            const LAS unsigned char* a1p = lds + (32 + (ql < 3 ? ql : 3)) * RT_PITCH + 64 * hi;
#pragma unroll 4
            for (int a = 0; a < 16; ++a) {
                bf16x8 xv[4];
#pragma unroll
                for (int i = 0; i < 4; ++i) xv[i] = *(const bf16x8*)(xr + 64 * a + 8 * i);
#pragma unroll
                for (int i = 0; i < 4; ++i) {
                    const bf16x8 w0 = *(const LAS bf16x8*)(a0p + 128 * a + 16 * i), w1 = *(const LAS bf16x8*)(a1p + 128 * a + 16 * i);
                    acc0 = __builtin_amdgcn_mfma_f32_32x32x16_bf16(w0, xv[i], acc0, 0, 0, 0);
                    acc1 = __builtin_amdgcn_mfma_f32_32x32x16_bf16(w1, xv[i], acc1, 0, 0, 0);
                }
            }
            { float sv[8];
#pragma unroll
              for (int j = 0; j < 8; ++j) sv[j] = SS[(size_t)(8 * hi + j) * T + t];
              float ssum = (sv[0] + sv[1]) + (sv[2] + sv[3]) + (sv[4] + sv[5]) + (sv[6] + sv[7]); ssum += __shfl_xor(ssum, 32); rstd = rsqrtf(ssum * (1.0f / D) + EPS); }
            float gl[4];
#pragma unroll
            for (int g = 0; g < 4; ++g) { const float o = __shfl_xor(acc1[g], 32); gl[g] = (hi ? o : acc1[g]) * rstd + brg[g]; }
            int grp = 0; float gm = gl[0];
#pragma unroll
            for (int g = 1; g < 4; ++g) if (gl[g] > gm) { gm = gl[g]; grp = g; }
            float den = 0.f;
#pragma unroll
            for (int g = 0; g < 4; ++g) den += __expf(gl[g] - gm);
            const float pg = 1.0f / den;
            float own[4], oth[4], el[8];
#pragma unroll
            for (int i = 0; i < 4; ++i) { const float v = grp == 0 ? acc0[i] : grp == 1 ? acc0[4 + i] : grp == 2 ? acc0[8 + i] : acc0[12 + i]; own[i] = v * rstd + bre[8 * grp + 4 * hi + i]; }
#pragma unroll
            for (int i = 0; i < 4; ++i) oth[i] = __shfl_xor(own[i], 32);
#pragma unroll
            for (int i = 0; i < 4; ++i) { el[i] = hi ? oth[i] : own[i]; el[4 + i] = hi ? own[i] : oth[i]; }
            int i1 = 0; float l1 = el[0];
#pragma unroll
            for (int i = 1; i < 8; ++i) if (el[i] > l1) { l1 = el[i]; i1 = i; }
            int i2 = -1; float l2 = -3.0e38f;
#pragma unroll
            for (int i = 0; i < 8; ++i) if (i != i1 && el[i] > l2) { l2 = el[i]; i2 = i; }
            if (i2 < 0) i2 = (i1 + 1) & 7;
            const float ex = __expf(l2 - l1);
            e0 = grp * 8 + i1; e1 = grp * 8 + i2; g0 = pg / (1.0f + ex); g1 = pg * ex / (1.0f + ex);
            if (hi == 0) { rank0 = __hip_atomic_fetch_add((LAS unsigned*)(lcnt + e0), 1u, __ATOMIC_RELAXED, __HIP_MEMORY_SCOPE_WORKGROUP); rank1 = __hip_atomic_fetch_add((LAS unsigned*)(lcnt + e1), 1u, __ATOMIC_RELAXED, __HIP_MEMORY_SCOPE_WORKGROUP); }
        }
        __syncthreads();
        if (tid < NE) { const unsigned n = lcnt[tid]; gbase[tid] = n ? atomicAdd(cnt + tid * 64, n) : 0u; lcnt[tid] = 0u; }
        __syncthreads();
        if (w < 4 && hi == 0) {
            const unsigned rb = cvt_pk_bf16(0.f, rstd) & 0xffff0000u;
            LISTS[(size_t)e0 * LCAP + gbase[e0] + rank0] = (int)(rb | (unsigned)(t * 2)); LISTS[(size_t)e1 * LCAP + gbase[e1] + rank1] = (int)(rb | (unsigned)(t * 2 + 1));
            *(float2*)(GATES + t * 2) = make_float2(g0, g1);
        }
    }
}

__device__ __forceinline__ void phase_combine(Frame& F, const float* gfinal, float* out) {
    const int gw = F.vcu * NWAVES + F.wave, NGW = F.G * NWAVES;
    bf16_t* XB = (bf16_t*)(F.ws + WS_XB); const bf16_t* YK = (const bf16_t*)(F.ws + WS_YK); float* RSTD = (float*)(F.ws + WS_RSTD); const float* GATES = (const float*)(F.ws + WS_GATES);
    f32x4 gf[2][2];
#pragma unroll
    for (int j = 0; j < 2; ++j) { const int c0 = 8 * (F.lane + 64 * j); gf[j][0] = gfinal ? *(const f32x4*)(gfinal + c0) : (f32x4){0.f, 0.f, 0.f, 0.f}; gf[j][1] = gfinal ? *(const f32x4*)(gfinal + c0 + 4) : (f32x4){0.f, 0.f, 0.f, 0.f}; }
    for (int t = gw; t < T; t += NGW) {
        u32x4* xr = (u32x4*)(XB + (size_t)t * D) + F.lane;
        const u32x4* y0 = (const u32x4*)(YK + (size_t)(2 * t) * D) + F.lane; const u32x4* y1 = (const u32x4*)(YK + (size_t)(2 * t + 1) * D) + F.lane;
        float v[2][8]; float s = 0.f; const float ga = GATES[2 * t], gb = GATES[2 * t + 1];
#pragma unroll
        for (int j = 0; j < 2; ++j) { const u32x4 a = xr[64 * j], b = y0[64 * j], c = y1[64 * j];
#pragma unroll
            for (int i = 0; i < 4; ++i) { v[j][2 * i] = bflo(a[i]) + ga * bflo(b[i]) + gb * bflo(c[i]); v[j][2 * i + 1] = bfhi(a[i]) + ga * bfhi(b[i]) + gb * bfhi(c[i]); s += v[j][2 * i] * v[j][2 * i] + v[j][2 * i + 1] * v[j][2 * i + 1]; } }
        s = wave_sum(s);
        const float rstd = rsqrtf(s * (1.0f / D) + EPS);
        if (gfinal) {
#pragma unroll
            for (int j = 0; j < 2; ++j) { const int c0 = 8 * (F.lane + 64 * j); const f32x4 g0 = gf[j][0], g1 = gf[j][1];
                f32x4 o0, o1;
#pragma unroll
                for (int i = 0; i < 4; ++i) { o0[i] = v[j][i] * rstd * g0[i]; o1[i] = v[j][4 + i] * rstd * g1[i]; }
                *(f32x4*)(out + (size_t)t * D + c0) = o0; *(f32x4*)(out + (size_t)t * D + c0 + 4) = o1; }
        } else {
            if (F.lane == 0) RSTD[t] = rstd;
#pragma unroll
            for (int j = 0; j < 2; ++j) { u32x4 w; w.x = cvt_pk_bf16(v[j][0], v[j][1]); w.y = cvt_pk_bf16(v[j][2], v[j][3]); w.z = cvt_pk_bf16(v[j][4], v[j][5]); w.w = cvt_pk_bf16(v[j][6], v[j][7]); xr[64 * j] = w; }
        }
    }
}

__device__ __forceinline__ void moe_setup(Frame& F, int l) {
    __syncthreads();
    if (F.tid < 64) {
        const int e = F.tid & 31;
        const unsigned c = __hip_atomic_load(F.ctl + CW_CNT + (l * NE + e) * 64, __ATOMIC_RELAXED, __HIP_MEMORY_SCOPE_AGENT);
        const unsigned tl = (c + 255u) / 256u;
        unsigned inc = tl;
#pragma unroll
        for (int o = 1; o < 32; o <<= 1) { const unsigned v = __shfl_up(inc, o, 32); if (e >= o) inc += v; }
        if (F.tid < 32) { F.MISC[64 + e] = c; F.MISC[16 + e] = inc - tl; if (e == 31) F.MISC[16 + NE] = inc; }
    }
    __syncthreads();
}

constexpr int N_PHASES = 1 + 7 * DEPTH;
__global__ void __launch_bounds__(NWAVES * 64, 2) mk_fwd(Args args) {
    extern __shared__ __attribute__((aligned(16))) unsigned char lds[];
    Frame F;
    F.lds = (LAS unsigned char*)lds; F.MISC = (volatile LAS unsigned*)(F.lds + MISC_OFF);
    F.wave = __builtin_amdgcn_readfirstlane((int)threadIdx.x >> 6); F.lane = lane_id(); F.tid = F.wave * 64 + F.lane;
    F.G = gridDim.x; { const int bx = blockIdx.x; F.vcu = (F.G % 8 == 0) ? (bx % 8) * (F.G / 8) + bx / 8 : bx; }
    F.ws = args.ws; F.ctl = (unsigned*)(args.ws + WS_CTL);
    for (int u = F.tid; u < 512; u += NWAVES * 64) F.MISC[u] = 0u;
    __syncthreads();
    if (F.tid == 0) {
        volatile LAS unsigned long long* pt = (volatile LAS unsigned long long*)(F.MISC + 128);
#define PT_(i) pt[i] = (unsigned long long)(uintptr_t)args.in[i];
        PT_(0) PT_(1) PT_(2) PT_(3) PT_(4) PT_(5) PT_(6) PT_(7) PT_(8) PT_(9) PT_(10) PT_(11) PT_(12) PT_(13) PT_(14) PT_(15) PT_(16)
#undef PT_
        pt[17] = (unsigned long long)(uintptr_t)args.out;
    }
    __syncthreads();
#if MK_ONE_LAUNCH
    XcdBarrier bar = xcd_barrier_post(F.ctl + CW_BAR, F.MISC + 0, F.tid);
#define GRID_BAR() xcd_barrier(bar, F.wave)
#else
#define GRID_BAR() do {} while (0)
#endif
    const int lo = args.ph_lo, hi = args.ph_hi;
#define IN(k) (lo <= (k) && (k) < hi)
#define SEAM(k) do { if (IN(k) && IN((k) + 1)) GRID_BAR(); } while (0)
    if (IN(0)) { relaunder(F); phase_prologue(F); SEAM(0); }
    for (int l = 0; l < DEPTH; ++l) {
        const int p = 1 + 7 * l;
        if (IN(p)) { relaunder(F);
            { const int ng = gemm_cus((T / 256) * 9, F.G); unsigned* ctr = F.ctl + CW_CONV + (l * 3 + 0) * 64;
              DenseSched<13> S{F.ws, l, ng, F.bx}; EpiG1 E{F.ws};
              const unsigned pk = pg8::gemm_phase<EpiG1, DenseSched<13>, false, true>(F.lds, F.MISC + 256, D, S, E, F.wave, ctr);
              relaunder(F);
              convert_work(F, ctr, cv_start(l, 0), cv_end(l, 0), F.bx >= ng, pk); }
            SEAM(p);
        }
        if (IN(p + 1)) { relaunder(F); phase_mixer(F, in_ptr(F, 3) + l * NH, in_ptr(F, 4) + (size_t)l * 3 * CW); SEAM(p + 1); }
        if (IN(p + 2)) { relaunder(F);
            DenseSched<2> S{F.ws, l, F.G, F.bx};
            EpiResid E{F.ws};
            pg8::gemm_phase<EpiResid, DenseSched<2>, false, true>(F.lds, F.MISC + 256, D, S, E, F.wave);
            relaunder(F); router_stage(F, l);
            SEAM(p + 2);
        }
        if (IN(p + 3)) { relaunder(F); if (!IN(p + 2)) router_stage(F, l); phase_router(F, l, in_ptr(F, 10) + l * NG, in_ptr(F, 12) + l * NE); SEAM(p + 3); }
        if (IN(p + 4)) { relaunder(F);
            moe_setup(F, l);
            const int ng = gemm_cus((int)F.MISC[16 + NE] * 4, F.G); unsigned* ctr = F.ctl + CW_CONV + (l * 3 + 1) * 64;
            MoeSched<true> S{F.ws, l, F.MISC, ng, F.bx};
            EpiAct E{S};
            const unsigned pk = pg8::gemm_phase<EpiAct, MoeSched<true>, true, true>(F.lds, F.MISC + 256, D, S, E, F.wave, ctr);
            relaunder(F);
            convert_work(F, ctr, cv_start(l, 1), cv_end(l, 1), F.bx >= ng, pk);
            SEAM(p + 4);
        }
        if (IN(p + 5)) { relaunder(F);
            const int ng = gemm_cus((int)F.MISC[16 + NE] * 4, F.G); unsigned* ctr = F.ctl + CW_CONV + (l * 3 + 2) * 64;
            MoeSched<false> S{F.ws, l, F.MISC, ng, F.bx};
            EpiDown E{S};
            const unsigned pk = pg8::gemm_phase<EpiDown, MoeSched<false>, false, true>(F.lds, F.MISC + 256, DE, S, E, F.wave, ctr);
            relaunder(F);
            convert_work(F, ctr, cv_start(l, 2), cv_end(l, 2), F.bx >= ng, pk);
            SEAM(p + 5);
        }
        if (IN(p + 6)) { relaunder(F); phase_combine(F, l == DEPTH - 1 ? in_ptr(F, 16) : nullptr, (float*)in_ptr(F, 17)); if (l < DEPTH - 1) SEAM(p + 6); }
    }
}

extern "C" void kernel_launch(void* const* d_in, const int* in_sizes, int n_in, void* d_out, int out_size, void* d_ws, size_t ws_size, hipStream_t stream) {
    static int grid = 0;
    if (grid == 0) {
        if (n_in != 17 || ws_size < WS_END) { fprintf(stderr, "kernel_launch: bad inputs (n_in %d, ws %zu)\n", n_in, ws_size); grid = -1; return; }
        int dev = 0, cus = 0, per_cu = 0;
        if (hipGetDevice(&dev) != hipSuccess || hipDeviceGetAttribute(&cus, hipDeviceAttributeMultiprocessorCount, dev) != hipSuccess) { grid = -1; return; }
        if (hipFuncSetAttribute((const void*)mk_fwd, hipFuncAttributeMaxDynamicSharedMemorySize, LDS_BYTES) != hipSuccess) { fprintf(stderr, "kernel_launch: hipFuncSetAttribute failed\n"); grid = -1; return; }
        if (hipOccupancyMaxActiveBlocksPerMultiprocessor(&per_cu, (const void*)mk_fwd, NWAVES * 64, LDS_BYTES) != hipSuccess || per_cu < 1) { fprintf(stderr, "kernel_launch: occupancy query says %d\n", per_cu); per_cu = 1; }
        (void)hipGetLastError();
        grid = cus;
    }
    if (grid < 0) return;
    (void)hipMemsetAsync((char*)d_ws + WS_CTL, 0, CTL_ZERO_BYTES, stream);
    Args a; memset(&a, 0, sizeof(a));
    for (int i = 0; i < 17; ++i) a.in[i] = (const float*)d_in[i];
    a.out = (float*)d_out; a.ws = (unsigned char*)d_ws;
#if MK_ONE_LAUNCH
    a.ph_lo = 0; a.ph_hi = N_PHASES;
    hipLaunchKernelGGL(mk_fwd, dim3(grid), dim3(NWAVES * 64), LDS_BYTES, stream, a);
#else
    for (int p = 0; p < N_PHASES; ++p) { a.ph_lo = p; a.ph_hi = p + 1; hipLaunchKernelGGL(mk_fwd, dim3(grid), dim3(NWAVES * 64), LDS_BYTES, stream, a); }
#endif
}
```

```cpp
#include <hip/hip_runtime.h>
#include <cstdio>
#include <cstdint>
#include <cstring>

#ifndef MK_ONE_LAUNCH
#define MK_ONE_LAUNCH 1
#endif

constexpr int D = 1024, BATCH = 4, SEQ = 8192, T = BATCH * SEQ, DEPTH = 4;
constexpr int NH = 8, HD = 64, AW = 512, CW = 512, INW = 2304;
constexpr int C_Q = 0, C_K = 512, C_V = 640, C_B = 768, C_C = 1280, C_U = 1792;
constexpr int PW = 1792, P_CU = 1280;
constexpr int NE = 32, NG = 4, DE = 512;
constexpr int WIN = 128;
constexpr float EPS = 1e-6f;
constexpr float QSCALE = 0.125f * 1.4426950408889634f;
constexpr float LOG2E = 1.4426950408889634f;
constexpr int LCAP = T;
constexpr int MAXSLOTS = 2 * T + NE * 256;

#define LAS __attribute__((address_space(3)))
#define GAS __attribute__((address_space(1)))
typedef unsigned short bf16_t;
typedef short bf16x8 __attribute__((ext_vector_type(8)));
typedef float f32x4 __attribute__((ext_vector_type(4)));
typedef unsigned u32x4 __attribute__((ext_vector_type(4)));
typedef unsigned u32x2 __attribute__((ext_vector_type(2)));

constexpr size_t MiB = 1u << 20;
constexpr size_t WS_CTL = 0, CTL_ZERO_BYTES = 128 * 1024;
constexpr size_t WS_CS = 1 * MiB;
constexpr size_t WS_RSTD = 2 * MiB;
constexpr size_t WS_SS = 3 * MiB;
constexpr size_t WS_GATES = 5 * MiB;
constexpr size_t WS_RSA = 5 * MiB + 512 * 1024;
constexpr size_t WS_LISTS = 6 * MiB;
constexpr size_t WS_WR = 10 * MiB;
constexpr size_t WS_WIN = 12 * MiB;
constexpr size_t WS_WOUT = 30 * MiB;
constexpr size_t WS_WGU = 40 * MiB;
constexpr size_t WS_WDN = 296 * MiB;
constexpr size_t WS_XB = 424 * MiB;
constexpr size_t WS_PROJ = 488 * MiB;
constexpr size_t WS_Y = 632 * MiB;
constexpr size_t WS_ACT = 696 * MiB;
constexpr size_t WS_YK = 768 * MiB;
constexpr size_t WS_DUMMY = 896 * MiB;
constexpr size_t WS_END = 897 * MiB;
constexpr int CW_BAR = 4096;
constexpr int CW_CONV = 8192;
constexpr int CW_CNT = 16384;

constexpr int RING_BYTES = 131072;
constexpr int MISC_OFF = RING_BYTES;
constexpr int LDS_BYTES = 147456;

__device__ __forceinline__ float bf2f(unsigned short b) { return __uint_as_float((unsigned)b << 16); }
__device__ __forceinline__ float bflo(unsigned w) { return __uint_as_float(w << 16); }
__device__ __forceinline__ float bfhi(unsigned w) { return __uint_as_float(w & 0xffff0000u); }
typedef float f32x2_t __attribute__((ext_vector_type(2)));
typedef __bf16 bf16x2_t __attribute__((ext_vector_type(2)));
__device__ __forceinline__ unsigned cvt_pk_bf16(float lo, float hi) { const f32x2_t v = {lo, hi}; const bf16x2_t b = __builtin_convertvector(v, bf16x2_t); return __builtin_bit_cast(unsigned, b); }
__device__ __forceinline__ float wave_sum(float v) {
#define WS_DPP(x, ctrl) __uint_as_float((unsigned)__builtin_amdgcn_update_dpp(0, (int)__float_as_uint(x), ctrl, 0xf, 0xf, false))
    v += WS_DPP(v, 0xB1); v += WS_DPP(v, 0x4E); v += WS_DPP(v, 0x124); v += WS_DPP(v, 0x128);
#undef WS_DPP
    { auto rr = __builtin_amdgcn_permlane16_swap(__float_as_uint(v), __float_as_uint(v), false, false); v = __uint_as_float(rr[0]) + __uint_as_float(rr[1]); }
    { auto rr = __builtin_amdgcn_permlane32_swap(__float_as_uint(v), __float_as_uint(v), false, false); v = __uint_as_float(rr[0]) + __uint_as_float(rr[1]); }
    return v;
}
__device__ __forceinline__ float xrow_sum(float v) { auto rr = __builtin_amdgcn_permlane16_swap(__float_as_uint(v), __float_as_uint(v), false, false); return __uint_as_float(rr[0]) + __uint_as_float(rr[1]); }
__device__ __forceinline__ float xhalf_other(float v, bool upper) { auto rr = __builtin_amdgcn_permlane32_swap(__float_as_uint(v), __float_as_uint(v), false, false); return __uint_as_float(upper ? rr[0] : rr[1]); }
__device__ __forceinline__ int lane_id() { int r; asm volatile("v_mbcnt_lo_u32_b32 %0, -1, 0\n\tv_mbcnt_hi_u32_b32 %0, -1, %0" : "=&v"(r)); return r; }
#define LDS_WAIT() asm volatile("s_waitcnt lgkmcnt(0)" ::: "memory")
#define VM_WAIT() asm volatile("s_waitcnt vmcnt(0)" ::: "memory")

namespace pg8 {
constexpr int BM = 256, BK = 64, HALF = 128, HTB = HALF * BK * 2, STAGE_BYTES = 8 * HTB, NXCD = 8, WGM = 8;
__host__ __device__ __forceinline__ int lds_byte(int r, int c) { const int st = (r >> 4) * 2 + (c >> 5), rr = r & 15, cc = c & 31, ob = rr * 64 + cc * 2; return st * 1024 + (ob ^ (((ob >> 9) & 1) << 5)); }
__host__ __device__ __forceinline__ void stage_rc(int b, int& R, int& C) { const int st = b / 1024, sb = b % 1024, swz = sb ^ (((sb >> 9) & 1) << 5); R = (st >> 1) * 16 + swz / 64; C = (st & 1) * 32 + (swz % 64) / 2; }
__host__ __device__ __forceinline__ int perm32(int rho) { const int n = rho >> 4, i = rho & 15; return 8 * (i >> 2) + 4 * n + (i & 3); }

struct Unit { int pm, pn, e, lt, nvalid; };

__device__ __forceinline__ bool tile_order(int L, int nM, int nN, int& pm, int& pn) {
    const int nwg = nM * nN; if (L >= nwg) return false;
    int wgid = L; { const int q = nwg / NXCD, r = nwg % NXCD, xcd = wgid % NXCD, off = wgid / NXCD; wgid = (xcd < r ? xcd * (q + 1) : r * (q + 1) + (xcd - r) * q) + off; }
    const int nig = WGM * nN, gid = wgid / nig, fm = gid * WGM, gsz = (nM - fm) < WGM ? (nM - fm) : WGM;
    pm = fm + ((wgid % nig) % gsz); pn = (wgid % nig) / gsz; return true;
}

template <class Epi, class Sched, bool GATHER, bool TABLE>
__device__ __forceinline__ unsigned gemm_phase(LAS unsigned char* lds, volatile LAS unsigned* tab, const int K, const Sched& S, const Epi& E, const int wave, unsigned* peek = nullptr) {
    int tid = wave * 64 + lane_id(); asm volatile("" : "+v"(tid));
    const int wid = wave, lane = tid & 63, wr = wid >> 2, wc = wid & 3, fr = lane & 15, fq = lane >> 4;
    const int nt = K / BK;
    constexpr int NST = Epi::NSTORE;
    unsigned voffB[2][2], cvo[2][2];
    {   int RR[2], CC[2];
#pragma unroll
        for (int i = 0; i < 2; ++i) { stage_rc(tid * 16 + i * 8192, RR[i], CC[i]); const int Rb = (RR[i] & ~31) + perm32(RR[i] & 31);
            voffB[0][i] = (unsigned)((64 * (RR[i] >> 5) + perm32(RR[i] & 31)) * K + CC[i]) * 2u; voffB[1][i] = voffB[0][i] + (unsigned)(32 * K * 2); (void)Rb;
            cvo[0][i] = (unsigned)(RR[i] * K + CC[i]) * 2u; cvo[1][i] = (unsigned)((RR[i] + HALF) * K + CC[i]) * 2u; } }
#define PG8_GATHER_VO(dst, tbl) do { int tid2_ = tid; asm volatile("" : "+v"(tid2_)); _Pragma("unroll") for (int i_ = 0; i_ < 2; ++i_) { int R_, C_; stage_rc(tid2_ * 16 + i_ * 8192, R_, C_); \
        _Pragma("unroll") for (int h_ = 0; h_ < 2; ++h_) dst[h_][i_] = (((tbl)[h_ * HALF + R_] & 0xfffeu) << 10) + (unsigned)C_ * 2u; } } while (0)
    const size_t kstep = (size_t)(BK * 2);
    const size_t hstep = (size_t)HALF * K * 2;
    const unsigned ldsw = (unsigned)wid * 1024u;
    const unsigned ldsbase = (unsigned)__builtin_amdgcn_readfirstlane((int)((unsigned)(uintptr_t)lds + ldsw));
    const int aoff = lds_byte(wr * 64 + fr, fq * 8), boff = lds_byte(wc * 32 + fr, fq * 8);
#define PG8_SA(b, h) (((b) * 2 + (h)) * HTB)
#define PG8_SB(b, h) ((4 + (b) * 2 + (h)) * HTB)
#define PG8_GLDS(gbase, voff32, ldsdst) do { unsigned keep_; asm volatile("s_mov_b32 %0, m0\n\ts_mov_b32 m0, %3\n\ts_nop 4\n\tglobal_load_lds_dwordx4 %1, %2\n\ts_mov_b32 m0, %0" \
        : "=&s"(keep_) : "v"(voff32), "s"(gbase), "s"(ldsdst) : "memory"); } while (0)
#define PG8_STAGE(bufoff, gbase, voff) do { _Pragma("unroll") for (int _i = 0; _i < 2; ++_i) \
        PG8_GLDS((const char*)(gbase), (voff)[_i], ldsbase + (unsigned)((bufoff) + _i * 8192)); } while (0)
#define PG8_LDA(dst, b, h) do { _Pragma("unroll") for (int m = 0; m < 4; ++m) _Pragma("unroll") for (int k = 0; k < 2; ++k) dst[m][k] = *(const LAS bf16x8*)(lds + PG8_SA(b, h) + aoff + m * 2048 + k * 1024); } while (0)
#define PG8_LDB(dst, b, h) do { _Pragma("unroll") for (int n = 0; n < 2; ++n) _Pragma("unroll") for (int k = 0; k < 2; ++k) dst[n][k] = *(const LAS bf16x8*)(lds + PG8_SB(b, h) + boff + n * 2048 + k * 1024); } while (0)
#define PG8_MMA(ai, bj, At, Bt) do { __builtin_amdgcn_s_setprio(1); _Pragma("unroll") for (int m = 0; m < 4; ++m) _Pragma("unroll") for (int n = 0; n < 2; ++n) _Pragma("unroll") for (int k = 0; k < 2; ++k) \
        acc[ai][bj][m][n] = __builtin_amdgcn_mfma_f32_16x16x32_bf16(Bt[n][k], At[m][k], acc[ai][bj][m][n], 0, 0, 0); __builtin_amdgcn_s_setprio(0); } while (0)
#define PG8_WAIT_V(n) asm volatile("s_waitcnt vmcnt(" #n ")" ::: "memory")
#define PG8_WAIT_VF(n) do { if (fresh) asm volatile("s_waitcnt vmcnt(%0)" :: "n"((n) + NST) : "memory"); else asm volatile("s_waitcnt vmcnt(8)" ::: "memory"); } while (0)
#define PG8_WAIT_L(n) asm volatile("s_waitcnt lgkmcnt(" #n ")" ::: "memory")
#define PG8_BAR __builtin_amdgcn_s_barrier()
#define PG8_SCHED __builtin_amdgcn_sched_barrier(0)
    Unit cur, nxt; int ui = 0;
    unsigned pk = 0u;
    if (!S.next(0, cur)) return 0u;
    f32x4 acc[2][2][4][2];
#pragma unroll
    for (int a = 0; a < 2; ++a)
#pragma unroll
        for (int b = 0; b < 2; ++b)
#pragma unroll
            for (int m = 0; m < 4; ++m)
#pragma unroll
                for (int n = 0; n < 2; ++n) acc[a][b][m][n] = (f32x4){0.f, 0.f, 0.f, 0.f};
    bf16x8 At[4][2], B0[2][2], B1[2][2];
    const char* cA = S.a_ptr(cur); const char* cB = S.b_ptr(cur);
    bool has_next = S.next(1, nxt);
    unsigned rinfo = 0u, rinfo0 = 0u;
    PG8_STAGE(PG8_SB(0, 0), cB, voffB[0]); PG8_STAGE(PG8_SB(0, 1), cB, voffB[1]);
    if constexpr (TABLE) {
        if (tid < 256) { rinfo0 = S.row_info(cur, tid); if (has_next) rinfo = S.row_info(nxt, tid); }
        if constexpr (GATHER) {
            if (tid < 256) tab[tid] = rinfo0;
            asm volatile("s_waitcnt vmcnt(0) lgkmcnt(0)" ::: "memory"); __builtin_amdgcn_s_barrier(); asm volatile("" ::: "memory");
            PG8_GATHER_VO(cvo, tab);
        }
    }
    int tb = 0;
    PG8_STAGE(PG8_SA(0, 0), cA, cvo[0]); PG8_STAGE(PG8_SA(0, 1), cA, cvo[1]);
    if (wr == 1) PG8_BAR;
    PG8_WAIT_V(2); PG8_BAR;
    if constexpr (TABLE && !GATHER) { if (tid < 256) tab[tid] = rinfo0; }
    PG8_STAGE(PG8_SB(1, 0), cB + kstep, voffB[0]); PG8_STAGE(PG8_SA(1, 0), cA + kstep, cvo[0]); PG8_STAGE(PG8_SB(1, 1), cB + kstep, voffB[1]);
    PG8_WAIT_V(6); PG8_BAR;
    for (;;) {
        const char* nA = has_next ? S.a_ptr(nxt) : cA; const char* nB = has_next ? S.b_ptr(nxt) : cB;
        Unit nn; const bool has_nn = has_next && S.next(ui + 2, nn);
        if (peek != nullptr && !has_next && tid == 0) pk = __hip_atomic_load(peek, __ATOMIC_RELAXED, __HIP_MEMORY_SCOPE_AGENT);
        if constexpr (TABLE) {
            { int t2 = tid; asm volatile("" : "+v"(t2));
              if (has_next) { if (t2 < 256) tab[(tb == 2 ? 0 : tb + 1) * 256 + t2] = rinfo; }
              if (has_nn) { if (t2 < 256) rinfo = S.row_info(nn, t2); } }
        }
        for (int t = 0; t < nt; t += 2) {
            const bool last = (t == nt - 2);
            const bool fresh = (t == 0) && (ui > 0);
            const char* a1 = cA + (size_t)(t + 1) * kstep;
            const char* a2 = last ? nA : cA + (size_t)(t + 2) * kstep; const char* b2 = last ? nB : cB + (size_t)(t + 2) * kstep;
            const char* a3 = a2 + kstep; const char* b3 = b2 + kstep;
            unsigned vo2[2][2];
#pragma unroll
            for (int h = 0; h < 2; ++h)
#pragma unroll
                for (int i = 0; i < 2; ++i) vo2[h][i] = cvo[h][i];
            if constexpr (GATHER) { if (last && has_next) PG8_GATHER_VO(vo2, tab + (tb == 2 ? 0 : tb + 1) * 256); }
            PG8_LDB(B0, 0, 0); PG8_LDB(B1, 0, 1); PG8_SCHED; PG8_LDA(At, 0, 0); if (!fresh) PG8_STAGE(PG8_SA(1, 1), a1, cvo[1]);
            PG8_WAIT_VF(8); PG8_WAIT_L(0); PG8_BAR; PG8_MMA(0, 0, At, B0); PG8_MMA(0, 1, At, B1); PG8_BAR; PG8_SCHED;
            PG8_LDA(At, 0, 1); PG8_STAGE(PG8_SB(0, 0), b2, voffB[0]); PG8_STAGE(PG8_SB(0, 1), b2, voffB[1]); PG8_STAGE(PG8_SA(0, 0), a2, vo2[0]);
            PG8_WAIT_VF(14); PG8_WAIT_L(0); PG8_BAR; PG8_MMA(1, 0, At, B0); PG8_MMA(1, 1, At, B1); PG8_BAR; PG8_SCHED;
            PG8_LDB(B0, 1, 0); PG8_LDB(B1, 1, 1); PG8_SCHED; PG8_LDA(At, 1, 0); PG8_STAGE(PG8_SA(0, 1), a2, vo2[1]);
            PG8_WAIT_VF(10); PG8_WAIT_L(0); PG8_BAR; PG8_MMA(0, 0, At, B0); PG8_MMA(0, 1, At, B1); PG8_BAR; PG8_SCHED;
            PG8_LDA(At, 1, 1); PG8_STAGE(PG8_SB(1, 0), b3, voffB[0]); PG8_STAGE(PG8_SB(1, 1), b3, voffB[1]); PG8_STAGE(PG8_SA(1, 0), a3, vo2[0]);
            PG8_WAIT_VF(14); PG8_WAIT_L(0); PG8_BAR; PG8_MMA(1, 0, At, B0); PG8_MMA(1, 1, At, B1); PG8_BAR; PG8_SCHED;
            if (last) PG8_STAGE(PG8_SA(1, 1), a3, vo2[1]);
            if constexpr (Epi::MIDSCALE) {
                if ((t + 2) * BK == Epi::MIDK) {
#pragma unroll
                    for (int a = 0; a < 2; ++a)
#pragma unroll
                        for (int m = 0; m < 4; ++m) { const float rsc = __uint_as_float(tab[tb * 256 + a * 128 + wr * 64 + m * 16 + fr]);
#pragma unroll
                            for (int b = 0; b < 2; ++b)
#pragma unroll
                                for (int n = 0; n < 2; ++n) acc[a][b][m][n] *= rsc; }
                }
            }
        }
        if (wr == 0) PG8_BAR;
        { int fr_ = fr, fq_ = fq; asm volatile("" : "+v"(fr_), "+v"(fq_)); E(acc, cur, wr, wc, fr_, fq_, tab + tb * 256); }
        if (!has_next) break;
#pragma unroll
        for (int a = 0; a < 2; ++a)
#pragma unroll
            for (int b = 0; b < 2; ++b)
#pragma unroll
                for (int m = 0; m < 4; ++m)
#pragma unroll
                    for (int n = 0; n < 2; ++n) acc[a][b][m][n] = (f32x4){0.f, 0.f, 0.f, 0.f};
        cur = nxt; cA = nA; cB = nB; ++ui; tb = (tb == 2 ? 0 : tb + 1); nxt = nn; has_next = has_nn;
        if constexpr (GATHER) PG8_GATHER_VO(cvo, tab + tb * 256);
        if (wr == 1) PG8_BAR;
    }
    PG8_WAIT_V(0);
    PG8_BAR;
    return pk;
#undef PG8_GATHER_VO
#undef PG8_SA
#undef PG8_SB
#undef PG8_STAGE
#undef PG8_GLDS
#undef PG8_LDA
#undef PG8_LDB
#undef PG8_MMA
#undef PG8_WAIT_V
#undef PG8_WAIT_VF
#undef PG8_WAIT_L
#undef PG8_BAR
#undef PG8_SCHED
}
}

#define XB_TMO      128
#define XB_XCNT(j)  (256  + 64 * (j))
#define XB_XSUB(j)  (1280 + 64 * (j))
#define XB_XGEN(j)  (2304 + 64 * (j))
#define XB_TOP      3328
#define XB_TOPGEN   3392
#define XCD_BAR_WORDS 3456
#define XB_SPIN_CAP (1u << 18)
__device__ __forceinline__ unsigned xb_ld(unsigned* p)              { return __hip_atomic_load(p, __ATOMIC_RELAXED, __HIP_MEMORY_SCOPE_AGENT); }
__device__ __forceinline__ unsigned xb_add(unsigned* p, unsigned v) { return __hip_atomic_fetch_add(p, v, __ATOMIC_RELAXED, __HIP_MEMORY_SCOPE_AGENT); }
__device__ __forceinline__ unsigned xb_xcc_id() { return (unsigned)__builtin_amdgcn_s_getreg((3 << 11) | 20) & 0xFu; }
#define XB_SPIN(cond, bar) do { unsigned _sp = 0; while (cond) { __builtin_amdgcn_s_sleep(1); \
    if ((++_sp & 255u) == 0u) { if (xb_ld(&(bar)[XB_TMO])) break; if (_sp > XB_SPIN_CAP) { atomicAdd(&(bar)[XB_TMO], 1u); break; } } } } while (0)
struct XcdBarrier { unsigned* bar; unsigned x; volatile LAS unsigned* st; };
__device__ __forceinline__ XcdBarrier xcd_barrier_post(unsigned* bar, volatile LAS unsigned* st, int tid) {
    XcdBarrier b; b.bar = bar; b.x = xb_xcc_id(); b.st = st;
    if (tid == 0) (void)xb_add(&bar[XB_XCNT(b.x)], 1u);
    return b;
}
__device__ __forceinline__ void xcd_barrier_complete(unsigned* bar, unsigned x, unsigned& nloc, unsigned& nx) {
    const unsigned G = gridDim.x * gridDim.y * gridDim.z;
    unsigned sum, cnt, mine, sp = 0u;
    for (;;) {
        sum = 0u; cnt = 0u; mine = 0u;
#pragma unroll
        for (unsigned j = 0; j < 16; ++j) { const unsigned c = xb_ld(&bar[XB_XCNT(j)]); sum += c; cnt += (c > 0u) ? 1u : 0u; mine = (j == x) ? c : mine; }
        if (sum == G) break;
        __builtin_amdgcn_s_sleep(1);
        if ((++sp & 255u) == 0u) { if (xb_ld(&bar[XB_TMO])) break; if (sp > XB_SPIN_CAP) { atomicAdd(&bar[XB_TMO], 1u); break; } }
    }
    nloc = mine > 0u ? mine : 1u; nx = cnt > 0u ? cnt : 1u;
}
__device__ __forceinline__ void xcd_barrier(const XcdBarrier& b, int wave) {
    asm volatile("s_waitcnt vmcnt(0)" ::: "memory");
    __syncthreads();
    if (wave == 0 && lane_id() == 0) {
        unsigned* bar = b.bar;
        __builtin_amdgcn_s_waitcnt(0);
        unsigned nloc = b.st[0], nx = b.st[1];
        if (nloc == 0u) { xcd_barrier_complete(bar, b.x, nloc, nx); b.st[0] = nloc; b.st[1] = nx; }
        const unsigned old = xb_add(&bar[XB_XSUB(b.x)], 1u);
        const unsigned gen = old / nloc;
        if (old + 1u == (gen + 1u) * nloc) {
            __builtin_amdgcn_fence(__ATOMIC_RELEASE, "agent");
            asm volatile("s_waitcnt vmcnt(0)" ::: "memory");
            (void)xb_add(&bar[XB_TOP], 1u);
        }
        XB_SPIN(xb_ld(&bar[XB_TOP]) < (gen + 1u) * nx, bar);
        __builtin_amdgcn_fence(__ATOMIC_ACQUIRE, "agent");
        asm volatile("s_waitcnt vmcnt(0)" ::: "memory");
    }
    __syncthreads();
}

struct Args {
    const float* in[17]; float* out; unsigned char* ws; int ph_lo, ph_hi;
};
struct Frame {
    LAS unsigned char* lds; volatile LAS unsigned* MISC; unsigned* ctl;
    int tid, lane, wave, vcu, G, bx;
    unsigned char* ws;
};
constexpr int NWAVES = 8;
__device__ __forceinline__ void relaunder(Frame& F) {
    unsigned m = (unsigned)(uintptr_t)F.MISC, d = (unsigned)(uintptr_t)F.lds; asm volatile("" : "+s"(m), "+s"(d));
    F.MISC = (volatile LAS unsigned*)(uintptr_t)m; F.lds = (LAS unsigned char*)(uintptr_t)d;
    asm volatile("" : "+s"(F.wave), "+s"(F.vcu));
    F.bx = (int)blockIdx.x; asm volatile("" : "+s"(F.bx));
    F.lane = lane_id(); F.tid = F.wave * 64 + F.lane;
    asm volatile("" : "+v"(F.tid), "+v"(F.lane));
    unsigned long long w = (unsigned long long)(uintptr_t)F.ws; asm volatile("" : "+s"(w)); F.ws = (unsigned char*)(GAS unsigned char*)(uintptr_t)w;
}
__device__ __forceinline__ const float* in_ptr(const Frame& F, int i) {
    volatile LAS unsigned* p = F.MISC + 128 + 2 * i;
    const unsigned lo = __builtin_amdgcn_readfirstlane(p[0]), hi = __builtin_amdgcn_readfirstlane(p[1]);
    return (const float*)(const GAS float*)(uintptr_t)(((unsigned long long)hi << 32) | lo);
}

template <int WHICH>
struct DenseSched {
    unsigned char* ws; int l, G, c;
    static constexpr int nM = T / 256, nN = WHICH == 1 ? 5 : WHICH == 13 ? 9 : 4, pn0 = WHICH == 3 ? 5 : 0;
    __device__ __forceinline__ int total() const { return nM * nN; }
    __device__ __forceinline__ bool next(int i, pg8::Unit& u) const {
        int pm, pn; if (c >= G || !pg8::tile_order(i * G + c, nM, nN, pm, pn)) return false;
        u.pm = pm; u.pn = pn + pn0; u.e = 0; u.lt = 0; u.nvalid = 256; return true;
    }
    __device__ __forceinline__ const char* a_ptr(const pg8::Unit& u) const { return (const char*)(ws + (WHICH == 2 ? WS_Y : WS_XB)) + (size_t)u.pm * 256 * D * 2; }
    __device__ __forceinline__ const char* b_ptr(const pg8::Unit& u) const {
        return WHICH == 2 ? (const char*)(ws + WS_WOUT) + ((size_t)l * D + u.pn * 256) * D * 2 : (const char*)(ws + WS_WIN) + ((size_t)l * INW + u.pn * 256) * D * 2; }
    __device__ __forceinline__ unsigned row_info(const pg8::Unit& u, int r) const { return ((const unsigned*)(ws + (WHICH == 2 ? WS_RSA : WS_RSTD)))[u.pm * 256 + r]; }
};
template <bool UP>
struct MoeSched {
    unsigned char* ws; int l; volatile LAS unsigned* misc; int G, c;
    __device__ __forceinline__ int total() const { return (int)misc[16 + NE] * 4; }
    __device__ __forceinline__ bool next(int i, pg8::Unit& u) const {
        const int nM = __builtin_amdgcn_readfirstlane((int)misc[16 + NE]); int pm, pn; if (c >= G || !pg8::tile_order(i * G + c, nM, 4, pm, pn)) return false;
        int ln = lane_id(); asm volatile("" : "+v"(ln)); ln &= 31;
        const int e = __popcll(__ballot((int)misc[16 + ln] <= pm)) / (int)(64 / NE) - 1;
        u.pm = pm; u.pn = pn; u.e = e; u.lt = pm - __builtin_amdgcn_readfirstlane((int)misc[16 + e]); const int rem = __builtin_amdgcn_readfirstlane((int)misc[64 + e]) - u.lt * 256; u.nvalid = rem < 256 ? rem : 256;
        return true;
    }
    __device__ __forceinline__ const char* a_ptr(const pg8::Unit& u) const { return UP ? (const char*)(ws + WS_XB) : (const char*)(ws + WS_ACT) + (size_t)u.pm * 256 * DE * 2; }
    __device__ __forceinline__ const char* b_ptr(const pg8::Unit& u) const {
        return UP ? (const char*)(ws + WS_WGU) + ((size_t)(l * NE + u.e) * 1024 + u.pn * 256) * D * 2 : (const char*)(ws + WS_WDN) + ((size_t)(l * NE + u.e) * D + u.pn * 256) * DE * 2; }
    __device__ __forceinline__ unsigned row_info(const pg8::Unit& u, int r) const { return r < u.nvalid ? ((const unsigned*)(ws + WS_LISTS))[(size_t)u.e * LCAP + u.lt * 256 + r] : (UP ? 0u : 0xffffffffu); }
};

typedef f32x4 Acc[2][2][4][2];
__device__ __forceinline__ u32x4 pack8(const f32x4 a, const f32x4 b) { u32x4 w; w.x = cvt_pk_bf16(a[0], a[1]); w.y = cvt_pk_bf16(a[2], a[3]); w.z = cvt_pk_bf16(b[0], b[1]); w.w = cvt_pk_bf16(b[2], b[3]); return w; }

__device__ __forceinline__ u32x4 xchg8(const u32x4 v) { u32x4 r;
#pragma unroll
    for (int q = 0; q < 4; ++q) r[q] = (unsigned)__builtin_amdgcn_update_dpp(0, (int)v[q], 0x128, 0xf, 0xf, false);
    return r; }
__device__ __forceinline__ float xrow16(float v, bool odd) { auto rr = __builtin_amdgcn_permlane16_swap(__float_as_uint(v), __float_as_uint(v), false, false); return __uint_as_float(odd ? rr[0] : rr[1]); }
struct EpiProj { static constexpr bool MIDSCALE = false; static constexpr int NSTORE = 16;
    unsigned char* ws;
    __device__ __forceinline__ void operator()(const Acc& acc, const pg8::Unit& u, int wr, int wc, int fr, int fq, volatile LAS unsigned* tab) const {
        bf16_t* O = (bf16_t*)(ws + WS_PROJ); const float* cs = (const float*)(ws + WS_CS);
        const int row0 = u.pm * 256 + wr * 64 + fr;
        const int cw = u.pn * 256 + wc * 64;
        const bool rope_wave = cw < C_V;
        const bool ropel = rope_wave && fq < 2;
        const bool lo = fr < 8;
        const int colp = cw + (lo ? 0 : 32) + 8 * fq;
        f32x4 c[4][4];
#define EPROJ_LOADC(ai_, m_) do { if (ropel) { const f32x4* c4 = (const f32x4*)(cs + (size_t)((row0 + (ai_) * 128 + (m_) * 16) & (SEQ - 1)) * 16); \
            _Pragma("unroll") for (int q = 0; q < 4; ++q) c[m_][q] = c4[q]; } else { _Pragma("unroll") for (int q = 0; q < 4; ++q) c[m_][q] = (f32x4){1.f, 0.f, 1.f, 0.f}; } } while (0)
#pragma unroll
        for (int m = 0; m < 4; ++m) EPROJ_LOADC(0, m);
#pragma unroll
        for (int ai = 0; ai < 2; ++ai) {
            float r[4];
#pragma unroll
            for (int m = 0; m < 4; ++m) r[m] = __uint_as_float(tab[ai * 128 + wr * 64 + m * 16 + fr]);
#pragma unroll
            for (int m = 0; m < 4; ++m) {
                f32x4 v0 = acc[ai][0][m][0] * r[m], v1 = acc[ai][0][m][1] * r[m];
                if (rope_wave) {
                    f32x4 o0, o1;
#pragma unroll
                    for (int j = 0; j < 4; ++j) { o0[j] = xrow16(v0[j], (fq & 1) != 0); o1[j] = xrow16(v1[j], (fq & 1) != 0); }
                    const float sg = fq == 0 ? -1.f : 1.f;
                    v0[0] = v0[0] * c[m][0][0] + sg * o0[0] * c[m][0][1]; v0[1] = v0[1] * c[m][0][2] + sg * o0[1] * c[m][0][3];
                    v0[2] = v0[2] * c[m][1][0] + sg * o0[2] * c[m][1][1]; v0[3] = v0[3] * c[m][1][2] + sg * o0[3] * c[m][1][3];
                    v1[0] = v1[0] * c[m][2][0] + sg * o1[0] * c[m][2][1]; v1[1] = v1[1] * c[m][2][2] + sg * o1[1] * c[m][2][3];
                    v1[2] = v1[2] * c[m][3][0] + sg * o1[2] * c[m][3][1]; v1[3] = v1[3] * c[m][3][2] + sg * o1[3] * c[m][3][3];
                }
                if (ai == 0) EPROJ_LOADC(1, m);
                const u32x4 p0 = pack8(v0, v1), p1 = pack8(acc[ai][1][m][0] * r[m], acc[ai][1][m][1] * r[m]);
                const u32x4 rcv = xchg8(lo ? p1 : p0);
                bf16_t* rl = O + (size_t)(row0 + ai * 128 + m * 16 - (lo ? 0 : 8)) * PW + colp;
                *(u32x4*)rl = lo ? p0 : rcv;
                *(u32x4*)(rl + (size_t)8 * PW) = lo ? rcv : p1;
            }
        }
#undef EPROJ_LOADC
    }
};
struct EpiCu { static constexpr bool MIDSCALE = false; static constexpr int NSTORE = 8;
    unsigned char* ws;
    __device__ __forceinline__ void operator()(const Acc& acc, const pg8::Unit& u, int wr, int wc, int fr, int fq, volatile LAS unsigned* tab) const {
        bf16_t* O = (bf16_t*)(ws + WS_PROJ);
        const int row0 = u.pm * 256 + wr * 64 + fr;
        float r2[8];
#pragma unroll
        for (int i = 0; i < 8; ++i) { const float rs = __uint_as_float(tab[(i >> 2) * 128 + wr * 64 + (i & 3) * 16 + fr]); r2[i] = rs * rs; }
#pragma unroll
        for (int ai = 0; ai < 2; ++ai)
#pragma unroll
            for (int m = 0; m < 4; ++m) {
                const f32x4 p0 = acc[ai][0][m][0] * acc[ai][1][m][0] * r2[ai * 4 + m], p1 = acc[ai][0][m][1] * acc[ai][1][m][1] * r2[ai * 4 + m];
                *(u32x4*)(O + (size_t)(row0 + ai * 128 + m * 16) * PW + P_CU + (u.pn - 5) * 128 + wc * 32 + 8 * fq) = pack8(p0, p1);
            }
    }
};
struct EpiG1 { static constexpr bool MIDSCALE = false; static constexpr int NSTORE = 8;
    unsigned char* ws;
    __device__ __forceinline__ void operator()(const Acc& acc, const pg8::Unit& u, int wr, int wc, int fr, int fq, volatile LAS unsigned* tab) const {
        if (u.pn < 5) { EpiProj E{ws}; E(acc, u, wr, wc, fr, fq, tab); } else { EpiCu E{ws}; E(acc, u, wr, wc, fr, fq, tab); }
    }
};
struct EpiResid { static constexpr bool MIDSCALE = true; static constexpr int MIDK = AW; static constexpr int NSTORE = 24;
    unsigned char* ws;
    __device__ __forceinline__ void operator()(const Acc& acc, const pg8::Unit& u, int wr, int wc, int fr, int fq, volatile LAS unsigned* tab) const {
        bf16_t* XB = (bf16_t*)(ws + WS_XB); float* SS = (float*)(ws + WS_SS);
        const int row0 = u.pm * 256 + wr * 64 + fr;
        const bool lo = fr < 8;
        const int colp = u.pn * 256 + wc * 64 + (lo ? 0 : 32) + 8 * fq;
        u32x4 xa[2][4], xb2[2][4];
#pragma unroll
        for (int ai = 0; ai < 2; ++ai)
#pragma unroll
            for (int m = 0; m < 4; ++m) { const bf16_t* rl = XB + (size_t)(row0 + ai * 128 + m * 16 - (lo ? 0 : 8)) * D + colp; xa[ai][m] = *(const u32x4*)rl; xb2[ai][m] = *(const u32x4*)(rl + (size_t)8 * D); }
#pragma unroll
        for (int ai = 0; ai < 2; ++ai) {
#pragma unroll
            for (int m = 0; m < 4; ++m) {
                const int row = row0 + ai * 128 + m * 16;
                const u32x4 r0 = xchg8(xa[ai][m]), r1 = xchg8(xb2[ai][m]);
                const u32x4 x0 = lo ? xa[ai][m] : r1, x1 = lo ? r0 : xb2[ai][m];
                f32x4 v00 = acc[ai][0][m][0], v01 = acc[ai][0][m][1], v10 = acc[ai][1][m][0], v11 = acc[ai][1][m][1];
                v00[0] += bflo(x0.x); v00[1] += bfhi(x0.x); v00[2] += bflo(x0.y); v00[3] += bfhi(x0.y); v01[0] += bflo(x0.z); v01[1] += bfhi(x0.z); v01[2] += bflo(x0.w); v01[3] += bfhi(x0.w);
                v10[0] += bflo(x1.x); v10[1] += bfhi(x1.x); v10[2] += bflo(x1.y); v10[3] += bfhi(x1.y); v11[0] += bflo(x1.z); v11[1] += bfhi(x1.z); v11[2] += bflo(x1.w); v11[3] += bfhi(x1.w);
                float sq = 0.f;
#pragma unroll
                for (int j = 0; j < 4; ++j) sq += v00[j] * v00[j] + v01[j] * v01[j] + v10[j] * v10[j] + v11[j] * v11[j];
                sq = xrow_sum(sq); { auto rr = __builtin_amdgcn_permlane32_swap(__float_as_uint(sq), __float_as_uint(sq), false, false); sq = __uint_as_float(rr[0]) + __uint_as_float(rr[1]); }
                if (fq == 0) SS[(size_t)(u.pn * 4 + wc) * T + row] = sq;
                const u32x4 p0 = pack8(v00, v01), p1 = pack8(v10, v11);
                const u32x4 rcv = xchg8(lo ? p1 : p0);
                bf16_t* rl = XB + (size_t)(row - (lo ? 0 : 8)) * D + colp;
                *(u32x4*)rl = lo ? p0 : rcv;
                *(u32x4*)(rl + (size_t)8 * D) = lo ? rcv : p1;
            }
        }
    }
};
struct EpiAct { static constexpr bool MIDSCALE = false; static constexpr int NSTORE = 8;
    MoeSched<true> S;
    __device__ __forceinline__ void operator()(const Acc& acc, const pg8::Unit& u, int wr, int wc, int fr, int fq, volatile LAS unsigned* tab) const {
        bf16_t* ACT = (bf16_t*)(S.ws + WS_ACT);
#pragma unroll
        for (int ai = 0; ai < 2; ++ai)
#pragma unroll
            for (int m = 0; m < 4; ++m) {
                const int r = ai * 128 + wr * 64 + m * 16 + fr; const float rs = __uint_as_float(tab[r] & 0xffff0000u);
                f32x4 o[2];
#pragma unroll
                for (int n = 0; n < 2; ++n)
#pragma unroll
                    for (int j = 0; j < 4; ++j) { const float g = acc[ai][0][m][n][j] * rs, up = acc[ai][1][m][n][j] * rs; o[n][j] = g * __builtin_amdgcn_rcpf(1.0f + __builtin_amdgcn_exp2f(-g * LOG2E)) * up; }
                *(u32x4*)(ACT + (size_t)(u.pm * 256 + r) * DE + u.pn * 128 + wc * 32 + 8 * fq) = pack8(o[0], o[1]);
            }
    }
};
struct EpiDown { static constexpr bool MIDSCALE = false; static constexpr int NSTORE = 16;
    MoeSched<false> S;
    __device__ __forceinline__ void operator()(const Acc& acc, const pg8::Unit& u, int wr, int wc, int fr, int fq, volatile LAS unsigned* tab) const {
        unsigned char* YK = S.ws + WS_YK;
        const bool lo = fr < 8;
        const unsigned colb = (unsigned)(u.pn * 256 + wc * 64 + (lo ? 0 : 32) + 8 * fq) * 2u;
#pragma unroll
        for (int ai = 0; ai < 2; ++ai)
#pragma unroll
            for (int m = 0; m < 4; ++m) {
                const unsigned q1 = tab[ai * 128 + wr * 64 + m * 16 + (fr & 7)], q2 = tab[ai * 128 + wr * 64 + m * 16 + 8 + (fr & 7)];
                const unsigned o1 = (q1 == 0xffffffffu ? (unsigned)(2 * T) : (q1 & 0xffffu)) * (unsigned)(D * 2) + colb, o2 = (q2 == 0xffffffffu ? (unsigned)(2 * T) : (q2 & 0xffffu)) * (unsigned)(D * 2) + colb;
                const u32x4 p0 = pack8(acc[ai][0][m][0], acc[ai][0][m][1]), p1 = pack8(acc[ai][1][m][0], acc[ai][1][m][1]);
                const u32x4 r0 = xchg8(p0), r1 = xchg8(p1);
                *(u32x4*)(YK + o1) = lo ? p0 : r1;
                *(u32x4*)(YK + o2) = lo ? r0 : p1;
                __builtin_amdgcn_sched_barrier(0);
            }
    }
};

__device__ __forceinline__ void p0_tile(const float* W, int ldw, int k0, int n0, bf16_t* WT, int Kt, int dst_row0, const float* gk, float cs, LAS unsigned char* scr, int lane, bool split = false) {
    const int r0 = lane >> 4, c = lane & 15;
    const float* src = W + (size_t)(k0 + 16 * r0) * ldw + n0 + 4 * c;
    f32x4 v[16];
#pragma unroll
    for (int i = 0; i < 16; ++i) v[i] = __builtin_nontemporal_load((const f32x4*)(src + (size_t)i * ldw));
    float g[16];
    if (gk) {
#pragma unroll
        for (int q = 0; q < 4; ++q) { const f32x4 t = *(const f32x4*)(gk + k0 + 16 * r0 + 4 * q); g[4 * q] = t[0] * cs; g[4 * q + 1] = t[1] * cs; g[4 * q + 2] = t[2] * cs; g[4 * q + 3] = t[3] * cs; }
    } else {
#pragma unroll
        for (int i = 0; i < 16; ++i) g[i] = cs;
    }
#pragma unroll
    for (int j = 0; j < 4; ++j) {
        u32x4 lo, hi2;
        lo.x = cvt_pk_bf16(v[0][j] * g[0], v[1][j] * g[1]); lo.y = cvt_pk_bf16(v[2][j] * g[2], v[3][j] * g[3]); lo.z = cvt_pk_bf16(v[4][j] * g[4], v[5][j] * g[5]); lo.w = cvt_pk_bf16(v[6][j] * g[6], v[7][j] * g[7]);
        hi2.x = cvt_pk_bf16(v[8][j] * g[8], v[9][j] * g[9]); hi2.y = cvt_pk_bf16(v[10][j] * g[10], v[11][j] * g[11]); hi2.z = cvt_pk_bf16(v[12][j] * g[12], v[13][j] * g[13]); hi2.w = cvt_pk_bf16(v[14][j] * g[14], v[15][j] * g[15]);
        const int n = 4 * c + j, sw = c & 7;
        *(LAS u32x4*)(scr + n * 128 + (((2 * r0) ^ sw) << 4)) = lo;
        *(LAS u32x4*)(scr + n * 128 + (((2 * r0 + 1) ^ sw) << 4)) = hi2;
    }
    LDS_WAIT(); asm volatile("" ::: "memory");
    const int ch = lane & 7;
#pragma unroll
    for (int i = 0; i < 8; ++i) { const int n = 8 * i + (lane >> 3);
        const u32x4 o = *(const LAS u32x4*)(scr + n * 128 + ((ch ^ ((n >> 2) & 7)) << 4));
        *(u32x4*)(WT + (size_t)(dst_row0 + n + (split ? 32 * (n >> 5) : 0)) * Kt + k0 + 8 * ch) = o; }
    LDS_WAIT(); asm volatile("" ::: "memory");
}
constexpr int CV_IN = 16 * 36, CV_OUT = 16 * 16, CV_G = NE * 128, CV_U = NE * 128, CV_D = NE * 128, CV_L = CV_IN + CV_OUT + CV_G + CV_U + CV_D;
__device__ __forceinline__ void convert_item(Frame& F, int l, int r, LAS unsigned char* scr) {
    unsigned char* ws = F.ws;
    if (r < CV_IN) { const int kb = r / 36, nb = r % 36;
        const int n0 = nb * 64;
        const int jc = n0 - C_C, ju = n0 - C_U;
        const int dst = n0 < C_C ? n0 : (n0 < C_U ? C_C + 256 * (jc / 128) + 2 * (jc % 128) : C_C + 256 * (ju / 128) + 2 * (ju % 128) + 32);
        p0_tile(in_ptr(F, 2) + (size_t)l * D * INW, INW, kb * 64, n0, (bf16_t*)(ws + WS_WIN) + (size_t)l * INW * D, D, dst, in_ptr(F, 1) + l * D, (n0 < C_K) ? QSCALE : 1.0f, scr, F.lane, n0 >= C_C); return; }
    r -= CV_IN;
    if (r < CV_OUT) { const int kb = r / 16, nb = r % 16; const int k0 = kb * 64;
        const float* gk = (k0 < AW) ? in_ptr(F, 5) + l * AW : in_ptr(F, 6) + l * CW - AW;
        p0_tile(in_ptr(F, 7) + (size_t)l * D * D, D, k0, nb * 64, (bf16_t*)(ws + WS_WOUT) + (size_t)l * D * D, D, nb * 64, gk, 1.0f, scr, F.lane); return; }
    r -= CV_OUT;
    if (r < CV_G + CV_U) { const int up = r >= CV_G; if (up) r -= CV_G; const int e = r / 128, q = r % 128, kb = q / 8, nb = q % 8; const int n0 = nb * 64;
        const float* W = in_ptr(F, up ? 14 : 13) + ((size_t)l * NE + e) * D * DE;
        p0_tile(W, DE, kb * 64, n0, (bf16_t*)(ws + WS_WGU) + ((size_t)l * NE + e) * 1024 * D, D, 256 * (n0 / 128) + 2 * (n0 % 128) + (up ? 32 : 0), in_ptr(F, 8) + l * D, 1.0f, scr, F.lane, true); return; }
    r -= CV_G + CV_U;
    { const int e = r / 128, q = r % 128, kb = q / 16, nb = q % 16;
      p0_tile(in_ptr(F, 15) + ((size_t)l * NE + e) * DE * D, D, kb * 64, nb * 64, (bf16_t*)(ws + WS_WDN) + ((size_t)l * NE + e) * D * DE, DE, nb * 64, nullptr, 1.0f, scr, F.lane); }
}
#ifndef CVX
#define CVX 4424
#define CVY 1344
#endif
#ifndef CV0
#define CV0 CVX
#endif
constexpr int CV_TOT = DEPTH * CV_L, CV_GUEND = CV_IN + CV_OUT + CV_G + CV_U;
static_assert(CVX >= CV_IN + CV_OUT && CVX <= CV_GUEND && CVY >= 0 && CVY <= CVX && CV0 >= CV_IN + CV_OUT && CV0 <= CV_GUEND, "conversion schedule");
__device__ __forceinline__ int cv_end(int l, int ph) { const int e = ph == 0 ? l * CV_L + CV_GUEND : ph == 1 ? (l + 1) * CV_L + CVY : (l + 1) * CV_L + CVX; return e < CV_TOT ? e : CV_TOT; }
__device__ __forceinline__ int cv_start(int l, int ph) { return ph == 0 ? (l == 0 ? CV0 : cv_end(l - 1, 2)) : cv_end(l, ph - 1); }
__device__ __forceinline__ int gemm_cus(int U, int G) { const int mx = (U + G - 1) / G; const int n = ((U + mx - 1) / mx + 7) & ~7; return n < G ? n : G; }
__device__ __forceinline__ void convert_work(Frame& F, unsigned* ctr, int start, int end, bool conv_cu, unsigned pk) {
    if (start >= end) return;
    const unsigned n = (unsigned)(end - start);
    volatile LAS unsigned* mb = F.MISC + 8;
    LAS unsigned char* scr = F.lds + F.wave * 16384;
    unsigned nxt = 0xffffffffu;
    if (F.tid == 0 && (conv_cu || pk < n)) nxt = __hip_atomic_fetch_add(ctr, 8u, __ATOMIC_RELAXED, __HIP_MEMORY_SCOPE_AGENT);
    for (;;) {
        if (F.tid == 0) mb[0] = nxt;
        __syncthreads();
        const unsigned base = mb[0];
        if (base >= n) break;
        if (F.tid == 0) nxt = __hip_atomic_fetch_add(ctr, 8u, __ATOMIC_RELAXED, __HIP_MEMORY_SCOPE_AGENT);
        const int it = start + (int)base + F.wave;
        if (it < end) convert_item(F, it / CV_L, it % CV_L, scr);
        __syncthreads();
    }
}
__device__ __forceinline__ void phase_prologue(Frame& F) {
    LAS unsigned char* scr = F.lds + F.wave * 16384;
    const int gw = F.vcu * NWAVES + F.wave, NGW = F.G * NWAVES;
    unsigned char* ws = F.ws;
    for (int it = gw; it < CV0; it += NGW) convert_item(F, it / CV_L, it % CV_L, scr);
    relaunder(F);
    {
        const int gt0 = F.vcu * 512 + F.tid, NGT0 = F.G * 512;
        for (int i = gt0; i < DEPTH * NE * D; i += NGT0) {
            const int l = i / (NE * D), e = (i / D) % NE, k = i % D;
            const float v = in_ptr(F, 11)[(size_t)l * D * NE + k * NE + e] * in_ptr(F, 8)[l * D + k];
            ((bf16_t*)(ws + WS_WR))[(size_t)l * 64 * D + (size_t)e * D + k] = (bf16_t)(cvt_pk_bf16(v, 0.f) & 0xffffu);
        }
    }
    const int gt = F.vcu * 512 + F.tid, NGT = F.G * 512;
    for (int i = gt; i < DEPTH * 32 * D; i += NGT) {
        const int l = i / (32 * D), rr = (i / D) % 32, k = i % D;
        float v = 0.f; if (rr < NG) v = in_ptr(F, 9)[(size_t)l * D * NG + k * NG + rr] * in_ptr(F, 8)[l * D + k];
        ((bf16_t*)(ws + WS_WR))[(size_t)l * 64 * D + (size_t)(32 + rr) * D + k] = (bf16_t)(cvt_pk_bf16(v, 0.f) & 0xffffu);
    }
    for (int i = gt; i < SEQ * 8; i += NGT) {
        const int pos = i >> 3, f = i & 7;
        const double ang = (double)pos * pow(500000.0, -(double)f / 8.0);
        ((float2*)(ws + WS_CS))[i] = make_float2((float)cos(ang), (float)sin(ang));
    }
    relaunder(F);
    const float* x = in_ptr(F, 0);
    for (int row = gw; row < T; row += NGW) {
        const f32x4* xr = (const f32x4*)(x + (size_t)row * D) + F.lane;
        f32x4 v[4]; float s = 0.f;
#pragma unroll
        for (int j = 0; j < 4; ++j) { v[j] = xr[64 * j]; s += v[j][0] * v[j][0] + v[j][1] * v[j][1] + v[j][2] * v[j][2] + v[j][3] * v[j][3]; }
        s = wave_sum(s);
        if (F.lane == 0) ((float*)(ws + WS_RSTD))[row] = rsqrtf(s * (1.0f / D) + EPS);
        u32x2* o = (u32x2*)((bf16_t*)(ws + WS_XB) + (size_t)row * D) + F.lane;
#pragma unroll
        for (int j = 0; j < 4; ++j) { u32x2 w; w.x = cvt_pk_bf16(v[j][0], v[j][1]); w.y = cvt_pk_bf16(v[j][2], v[j][3]); o[64 * j] = w; }
    }
}

typedef float f32x16 __attribute__((ext_vector_type(16)));
typedef short v4i16 __attribute__((ext_vector_type(4)));
constexpr int ATT_K_OFF = 0, ATT_V_OFF = 49152, ATT_STG_OFF = 98304;
constexpr int SSQ_WORD = 1024, RSQ_WORD = 2048;
__device__ __forceinline__ int crow(int r, int hi) { return (r & 3) + 8 * (r >> 2) + 4 * hi; }

__device__ __forceinline__ float xhalf_max(float v) { auto rr = __builtin_amdgcn_permlane32_swap(__float_as_uint(v), __float_as_uint(v), false, false); return fmaxf(__uint_as_float(rr[0]), __uint_as_float(rr[1])); }
__device__ __forceinline__ float xhalf_sum(float v) { auto rr = __builtin_amdgcn_permlane32_swap(__float_as_uint(v), __float_as_uint(v), false, false); return __uint_as_float(rr[0]) + __uint_as_float(rr[1]); }
template <int MASK>
__device__ __forceinline__ void attn_step(LAS unsigned char* lds, int kt, const bf16x8 (&qf)[4], const unsigned (&koff)[4], const unsigned (&vb)[2], int ql, int hi, float& m, float& l, f32x16 (&o)[2], f32x16& negm) {
    const LAS unsigned char* kb = lds + ATT_K_OFF + kt * 4096;
    const LAS unsigned char* vbase = lds + ATT_V_OFF + kt * 4096;
    bf16x8 kf[4];
#pragma unroll
    for (int ks = 0; ks < 4; ++ks) kf[ks] = *(const LAS bf16x8*)(kb + koff[ks]);
    f32x16 sacc = __builtin_amdgcn_mfma_f32_32x32x16_bf16(kf[0], qf[0], negm, 0, 0, 0);
#pragma unroll
    for (int ks = 1; ks < 4; ++ks) sacc = __builtin_amdgcn_mfma_f32_32x32x16_bf16(kf[ks], qf[ks], sacc, 0, 0, 0);
    v4i16 va[4], vc[4];
#pragma unroll
    for (int i = 0; i < 4; ++i) {
        va[i] = __builtin_amdgcn_ds_read_tr16_b64_v4i16((LAS v4i16*)(vbase + vb[i >> 1] + (i & 1) * 2048));
        vc[i] = __builtin_amdgcn_ds_read_tr16_b64_v4i16((LAS v4i16*)(vbase + vb[i >> 1] + (i & 1) * 2048 + 1024));
    }
    if (MASK == 1) {
#pragma unroll
        for (int r = 0; r < 16; ++r) if (crow(r, hi) < ql) sacc[r] = -1e30f;
    }
    if (MASK == 2) {
#pragma unroll
        for (int r = 0; r < 16; ++r) if (crow(r, hi) > ql) sacc[r] = -1e30f;
    }
    float mx = sacc[0];
#pragma unroll
    for (int r = 1; r < 16; ++r) mx = fmaxf(mx, sacc[r]);
    mx = xhalf_max(mx);
    if (!__all(mx <= 8.0f)) {
        asm volatile("" ::: "memory");
        const float d = fmaxf(mx, 0.f), alpha = __builtin_amdgcn_exp2f(-d);
        l *= alpha;
#pragma unroll
        for (int r = 0; r < 16; ++r) { o[0][r] *= alpha; o[1][r] *= alpha; sacc[r] -= d; negm[r] -= d; }
        m += d;
    }
    float ps = 0.f;
#pragma unroll
    for (int r = 0; r < 16; ++r) { sacc[r] = __builtin_amdgcn_exp2f(sacc[r]); ps += sacc[r]; }
    l += ps;
    bf16x8 pf[2];
#pragma unroll
    for (int s2 = 0; s2 < 2; ++s2) {
        u32x4 w; w.x = cvt_pk_bf16(sacc[8 * s2 + 0], sacc[8 * s2 + 1]); w.y = cvt_pk_bf16(sacc[8 * s2 + 2], sacc[8 * s2 + 3]); w.z = cvt_pk_bf16(sacc[8 * s2 + 4], sacc[8 * s2 + 5]); w.w = cvt_pk_bf16(sacc[8 * s2 + 6], sacc[8 * s2 + 7]);
        pf[s2] = __builtin_bit_cast(bf16x8, w);
    }
#pragma unroll
    for (int i = 0; i < 4; ++i) {
        const bf16x8 vf = (bf16x8){va[i][0], va[i][1], va[i][2], va[i][3], vc[i][0], vc[i][1], vc[i][2], vc[i][3]};
        o[i >> 1] = __builtin_amdgcn_mfma_f32_32x32x16_bf16(vf, pf[i & 1], o[i >> 1], 0, 0, 0);
    }
}

__device__ __forceinline__ void phase_mixer(Frame& F, const float* sink, const float* cw) {
    const bf16_t* P = (const bf16_t*)(F.ws + WS_PROJ);
    bf16_t* Y = (bf16_t*)(F.ws + WS_Y);
    const int tid = F.tid, lane = F.lane, w = F.wave;
    const int ql = lane & 31, hi = lane >> 5;
    LAS unsigned char* lds = F.lds;
    volatile LAS float* ssq = (volatile LAS float*)(F.MISC + SSQ_WORD);
    volatile LAS float* rsq = (volatile LAS float*)(F.MISC + RSQ_WORD);
    unsigned koff[4], vb[2];
#pragma unroll
    for (int ks = 0; ks < 4; ++ks) koff[ks] = (unsigned)(ql * 128 + (((2 * ks + hi) ^ ((ql >> 1) & 7)) << 4));
    { const int g = (lane >> 4) & 1, li = lane & 15, q = li >> 2, p = li & 3, sw = (q >> 1) & 1;
      vb[0] = (unsigned)((4 * hi + q) * 128 + 64 * sw + 32 * g + 8 * p); vb[1] = (unsigned)((4 * hi + q) * 128 + 64 * (1 - sw) + 32 * g + 8 * p); }
    for (int unit = F.vcu; unit < BATCH * (SEQ / 128); unit += F.G) {
        const int b = unit / (SEQ / 128), n = unit % (SEQ / 128);
        const size_t tok0 = (size_t)b * SEQ + (size_t)n * 128;
#pragma unroll 1
        for (int part = 0; part < 2; ++part) {
        if ((part == 0) != ((F.vcu & 1) != 0)) {
        u32x4 kv[6], vv[6];
#define ATT_LOAD_K(kvh_) do { _Pragma("unroll") for (int i = 0; i < 6; ++i) { const int idx = tid + 512 * i, key = idx >> 3, ch = idx & 7; \
            const int kpos = (n - 1) * 128 + key; const int kc = kpos < 0 ? 0 : (kpos >= SEQ ? SEQ - 1 : kpos); \
            kv[i] = *(const u32x4*)(P + ((size_t)b * SEQ + kc) * PW + (kvh_) * HD + ch * 8 + C_K); } } while (0)
#define ATT_LOAD_V(kvh_) do { _Pragma("unroll") for (int i = 0; i < 6; ++i) { const int idx = tid + 512 * i, key = idx >> 3, ch = idx & 7; \
            const int kpos = (n - 1) * 128 + key; const int kc = kpos < 0 ? 0 : (kpos >= SEQ ? SEQ - 1 : kpos); \
            vv[i] = *(const u32x4*)(P + ((size_t)b * SEQ + kc) * PW + (kvh_) * HD + ch * 8 + C_V); } } while (0)
        { int tid = F.tid; asm volatile("" : "+v"(tid)); ATT_LOAD_K(0); ATT_LOAD_V(0); }
#pragma unroll
        for (int kvh = 0; kvh < 2; ++kvh) {
            int tid = F.tid; asm volatile("" : "+v"(tid));
            if (kvh == 1) ATT_LOAD_V(1);
            __syncthreads();
            const int head = kvh * 4 + (w >> 1), qh = w & 1;
#pragma unroll
            for (int i = 0; i < 6; ++i) {
                const int idx = tid + 512 * i, key = idx >> 3, ch = idx & 7;
                const int kpos = (n - 1) * 128 + key; const bool ok = kpos >= 0 && kpos < SEQ;
                const u32x4 z = (u32x4){0u, 0u, 0u, 0u};
                *(LAS u32x4*)(lds + ATT_K_OFF + key * 128 + ((ch ^ ((key >> 1) & 7)) << 4)) = ok ? kv[i] : z;
                *(LAS u32x4*)(lds + ATT_V_OFF + key * 128 + ((ch ^ (((key >> 1) & 1) << 2)) << 4)) = ok ? vv[i] : z;
            }
            if (kvh == 0) ATT_LOAD_K(1);
            __syncthreads();
            const float sk = sink[head] * LOG2E;
#pragma unroll
            for (int qt = 0; qt < 2; ++qt) {
                int lane_q = lane; asm volatile("" : "+v"(lane_q)); const int ql = lane_q & 31, hi = lane_q >> 5;
                const int q0 = 64 * qh + 32 * qt;
                const bf16_t* qrow = P + (tok0 + q0 + ql) * PW + C_Q + head * HD + 8 * hi;
                bf16x8 qf[4];
#pragma unroll
                for (int ks = 0; ks < 4; ++ks) qf[ks] = *(const bf16x8*)(qrow + 16 * ks);
                float m = sk, l = hi == 0 ? 1.f : 0.f;
                f32x16 negm;
#pragma unroll
                for (int r = 0; r < 16; ++r) negm[r] = -sk;
                f32x16 o[2];
#pragma unroll
                for (int r = 0; r < 16; ++r) { o[0][r] = 0.f; o[1][r] = 0.f; }
                const int kt0 = q0 >> 5;
                if (n - 1 + (kt0 >> 2) >= 0) attn_step<1>(lds, kt0, qf, koff, vb, ql, hi, m, l, o, negm);
#pragma unroll 1
                for (int j = 1; j < 8; ++j) { const int kt = kt0 + j; const int gb = n - 1 + (kt >> 2); if (gb >= 0 && gb < SEQ / 128) attn_step<0>(lds, kt, qf, koff, vb, ql, hi, m, l, o, negm); }
                if (n - 1 + ((kt0 + 8) >> 2) < SEQ / 128) attn_step<2>(lds, kt0 + 8, qf, koff, vb, ql, hi, m, l, o, negm);
                const float lt = xhalf_sum(l);
                const float inv = 1.0f / lt;
                float sq = 0.f;
#pragma unroll
                for (int dt = 0; dt < 2; ++dt)
#pragma unroll
                    for (int r = 0; r < 16; ++r) { o[dt][r] *= inv; sq += o[dt][r] * o[dt][r]; }
                sq = xhalf_sum(sq);
                if (hi == 0) ssq[head * 128 + q0 + ql] = sq;
                {   LAS unsigned char* stg = lds + ATT_STG_OFF + w * 4096;
#pragma unroll
                    for (int dt = 0; dt < 2; ++dt)
#pragma unroll
                        for (int g = 0; g < 4; ++g) {
                            const int c8 = 4 * dt + g;
                            u32x2 wv; wv.x = cvt_pk_bf16(o[dt][4 * g], o[dt][4 * g + 1]); wv.y = cvt_pk_bf16(o[dt][4 * g + 2], o[dt][4 * g + 3]);
                            *(LAS u32x2*)(stg + ql * 128 + ((c8 ^ (ql & 7)) << 4) + 8 * hi) = wv; }
                    asm volatile("s_waitcnt lgkmcnt(0)" ::: "memory");
#pragma unroll
                    for (int i = 0; i < 4; ++i) { const int row = 8 * i + (lane_q >> 3), ch = lane_q & 7;
                        const u32x4 v = *(const LAS u32x4*)(stg + row * 128 + ((ch ^ (row & 7)) << 4));
                        *(u32x4*)(Y + (tok0 + q0 + row) * D + head * HD + 8 * ch) = v; }
                    asm volatile("s_waitcnt lgkmcnt(0)" ::: "memory");
                }
            }
        }
        __syncthreads();
        if (tid < 128) { float s = 0.f;
#pragma unroll
            for (int h = 0; h < 8; ++h) s += ssq[h * 128 + tid];
            ((float*)(F.ws + WS_RSA))[tok0 + tid] = rsqrtf(s * (1.0f / AW) + EPS); }
        } else
        {
            int lane_c = lane; asm volatile("" : "+v"(lane_c));
            float cwv[3][8];
#pragma unroll
            for (int k = 0; k < 3; ++k) { const f32x4 a = *(const f32x4*)(cw + k * CW + 8 * lane_c), b2 = *(const f32x4*)(cw + k * CW + 8 * lane_c + 4);
#pragma unroll
                for (int jj = 0; jj < 4; ++jj) { cwv[k][jj] = a[jj]; cwv[k][4 + jj] = b2[jj]; } }
#pragma unroll 1
            for (int bt = 0; bt < 2; ++bt) {
                const int p0 = n * 128 + 16 * w + 8 * bt;
                const bf16_t* pr0 = P + (tok0 + 16 * w + 8 * bt) * PW;
                const u32x4 zero = (u32x4){0u, 0u, 0u, 0u};
                u32x4 cc[10], bb[8];
#pragma unroll
                for (int r = 0; r < 10; ++r) { const int pos = p0 - 1 + r; const bool ok = pos >= 0 && pos < SEQ;
                    cc[r] = ok ? *(const u32x4*)(pr0 + (ptrdiff_t)(r - 1) * PW + P_CU + 8 * lane_c) : zero; }
#pragma unroll
                for (int r = 0; r < 8; ++r) bb[r] = *(const u32x4*)(pr0 + (size_t)r * PW + C_B + 8 * lane_c);
                float cu[10][8];
#pragma unroll
                for (int r = 0; r < 10; ++r)
#pragma unroll
                    for (int wi = 0; wi < 4; ++wi) { cu[r][2 * wi] = bflo(cc[r][wi]); cu[r][2 * wi + 1] = bfhi(cc[r][wi]); }
#pragma unroll
                for (int r = 0; r < 8; ++r) {
                    float yc[8]; float s2 = 0.f;
#pragma unroll
                    for (int jj = 0; jj < 8; ++jj) {
                        const float gb = (jj & 1) ? bfhi(bb[r][jj >> 1]) : bflo(bb[r][jj >> 1]);
                        yc[jj] = gb * (cwv[0][jj] * cu[r][jj] + cwv[1][jj] * cu[r + 1][jj] + cwv[2][jj] * cu[r + 2][jj]); s2 += yc[jj] * yc[jj];
                    }
                    s2 = wave_sum(s2);
                    const float rstd = rsqrtf(s2 * (1.0f / CW) + EPS);
                    u32x4 wv; wv.x = cvt_pk_bf16(yc[0] * rstd, yc[1] * rstd); wv.y = cvt_pk_bf16(yc[2] * rstd, yc[3] * rstd); wv.z = cvt_pk_bf16(yc[4] * rstd, yc[5] * rstd); wv.w = cvt_pk_bf16(yc[6] * rstd, yc[7] * rstd);
                    *(u32x4*)(Y + (tok0 + 16 * w + 8 * bt + r) * D + AW + 8 * lane_c) = wv;
                }
            }
        }
        }
    }
}


constexpr int RT_PITCH = 2064;
constexpr int LCNT_WORD = 2304, GBASE_WORD = 2368;
__device__ __forceinline__ void router_stage(Frame& F, int l) {
    const bf16_t* WR = (const bf16_t*)(F.ws + WS_WR) + (size_t)l * 64 * D;
    const int tid = F.tid; LAS unsigned char* lds = F.lds;
    __syncthreads();
    u32x4 wv[9];
#pragma unroll
    for (int j = 0; j < 9; ++j) { const int i = tid + 512 * j; wv[j] = *(const u32x4*)(WR + (size_t)(i >> 7) * D + (i & 127) * 8); }
#pragma unroll
    for (int j = 0; j < 9; ++j) { const int i = tid + 512 * j; *(LAS u32x4*)(lds + (i >> 7) * RT_PITCH + (i & 127) * 16) = wv[j]; }
}
__device__ __forceinline__ void phase_router(Frame& F, int l, const float* brg, const float* bre) {
    const bf16_t* XB = (const bf16_t*)(F.ws + WS_XB);
    const float* SS = (const float*)(F.ws + WS_SS);
    float* RSTD = (float*)(F.ws + WS_RSTD); float* GATES = (float*)(F.ws + WS_GATES); int* LISTS = (int*)(F.ws + WS_LISTS);
    unsigned* cnt = F.ctl + CW_CNT + l * NE * 64;
    const int tid = F.tid, lane = F.lane, w = F.wave, ql = lane & 31, hi = lane >> 5;
    LAS unsigned char* lds = F.lds;
    volatile LAS unsigned* lcnt = F.MISC + LCNT_WORD; volatile LAS unsigned* gbase = F.MISC + GBASE_WORD;
    if (tid < NE) lcnt[tid] = 0u;
    __syncthreads();
    for (int unit = F.vcu; unit < T / 128; unit += F.G) {
        int e0 = 0, e1 = 0; unsigned rank0 = 0, rank1 = 0; float g0 = 0.f, g1 = 0.f, rstd = 0.f;
        const int t = unit * 128 + 32 * w + ql;
        if (w < 4) {
            f32x16 acc0, acc1;
#pragma unroll
            for (int r = 0; r < 16; ++r) { acc0[r] = 0.f; acc1[r] = 0.f; }
            const bf16_t* xr = XB + (size_t)t * D + 32 * hi;
            const LAS unsigned char* a0p = lds + ql * RT_PITCH + 64 * hi;
            const LAS unsigned char* a1p = lds + (32 + (ql < 3 ? ql : 3)) * RT_PITCH + 64 * hi;
#pragma unroll 4
            for (int a = 0; a < 16; ++a) {
                bf16x8 xv[4];
#pragma unroll
                for (int i = 0; i < 4; ++i) xv[i] = *(const bf16x8*)(xr + 64 * a + 8 * i);
#pragma unroll
                for (int i = 0; i < 4; ++i) {
                    const bf16x8 w0 = *(const LAS bf16x8*)(a0p + 128 * a + 16 * i), w1 = *(const LAS bf16x8*)(a1p + 128 * a + 16 * i);
                    acc0 = __builtin_amdgcn_mfma_f32_32x32x16_bf16(w0, xv[i], acc0, 0, 0, 0);
                    acc1 = __builtin_amdgcn_mfma_f32_32x32x16_bf16(w1, xv[i], acc1, 0, 0, 0);
                }
            }
            { float sv[8];
#pragma unroll
              for (int j = 0; j < 8; ++j) sv[j] = SS[(size_t)(8 * hi + j) * T + t];
              float ssum = (sv[0] + sv[1]) + (sv[2] + sv[3]) + (sv[4] + sv[5]) + (sv[6] + sv[7]); { auto rr = __builtin_amdgcn_permlane32_swap(__float_as_uint(ssum), __float_as_uint(ssum), false, false); ssum = __uint_as_float(rr[0]) + __uint_as_float(rr[1]); } rstd = rsqrtf(ssum * (1.0f / D) + EPS); }
            float gl[4];
#pragma unroll
            for (int g = 0; g < 4; ++g) { const float o = xhalf_other(acc1[g], hi != 0); gl[g] = (hi ? o : acc1[g]) * rstd + brg[g]; }
            int grp = 0; float gm = gl[0];
#pragma unroll
            for (int g = 1; g < 4; ++g) if (gl[g] > gm) { gm = gl[g]; grp = g; }
            float den = 0.f;
#pragma unroll
            for (int g = 0; g < 4; ++g) den += __expf(gl[g] - gm);
            const float pg = 1.0f / den;
            float own[4], oth[4], el[8];
#pragma unroll
            for (int i = 0; i < 4; ++i) { const float v = grp == 0 ? acc0[i] : grp == 1 ? acc0[4 + i] : grp == 2 ? acc0[8 + i] : acc0[12 + i]; own[i] = v * rstd + bre[8 * grp + 4 * hi + i]; }
#pragma unroll
            for (int i = 0; i < 4; ++i) oth[i] = xhalf_other(own[i], hi != 0);
#pragma unroll
            for (int i = 0; i < 4; ++i) { el[i] = hi ? oth[i] : own[i]; el[4 + i] = hi ? own[i] : oth[i]; }
            int i1 = 0; float l1 = el[0];
#pragma unroll
            for (int i = 1; i < 8; ++i) if (el[i] > l1) { l1 = el[i]; i1 = i; }
            int i2 = -1; float l2 = -3.0e38f;
#pragma unroll
            for (int i = 0; i < 8; ++i) if (i != i1 && el[i] > l2) { l2 = el[i]; i2 = i; }
            if (i2 < 0) i2 = (i1 + 1) & 7;
            const float ex = __expf(l2 - l1);
            e0 = grp * 8 + i1; e1 = grp * 8 + i2; g0 = pg / (1.0f + ex); g1 = pg * ex / (1.0f + ex);
            if (hi == 0) { rank0 = __hip_atomic_fetch_add((LAS unsigned*)(lcnt + e0), 1u, __ATOMIC_RELAXED, __HIP_MEMORY_SCOPE_WORKGROUP); rank1 = __hip_atomic_fetch_add((LAS unsigned*)(lcnt + e1), 1u, __ATOMIC_RELAXED, __HIP_MEMORY_SCOPE_WORKGROUP); }
        }
        __syncthreads();
        if (tid < NE) { const unsigned n = lcnt[tid]; gbase[tid] = n ? atomicAdd(cnt + tid * 64, n) : 0u; lcnt[tid] = 0u; }
        __syncthreads();
        if (w < 4 && hi == 0) {
            const unsigned rb = cvt_pk_bf16(0.f, rstd) & 0xffff0000u;
            LISTS[(size_t)e0 * LCAP + gbase[e0] + rank0] = (int)(rb | (unsigned)(t * 2)); LISTS[(size_t)e1 * LCAP + gbase[e1] + rank1] = (int)(rb | (unsigned)(t * 2 + 1));
            *(float2*)(GATES + t * 2) = make_float2(g0, g1);
        }
    }
}

__device__ __forceinline__ void phase_combine(Frame& F, const float* gfinal, float* out) {
    const int gw = F.vcu * NWAVES + F.wave, NGW = F.G * NWAVES;
    bf16_t* XB = (bf16_t*)(F.ws + WS_XB); const bf16_t* YK = (const bf16_t*)(F.ws + WS_YK); float* RSTD = (float*)(F.ws + WS_RSTD); const float* GATES = (const float*)(F.ws + WS_GATES);
    f32x4 gf[2][2];
#pragma unroll
    for (int j = 0; j < 2; ++j) { const int c0 = 8 * (F.lane + 64 * j); gf[j][0] = gfinal ? *(const f32x4*)(gfinal + c0) : (f32x4){0.f, 0.f, 0.f, 0.f}; gf[j][1] = gfinal ? *(const f32x4*)(gfinal + c0 + 4) : (f32x4){0.f, 0.f, 0.f, 0.f}; }
    for (int t = gw; t < T; t += NGW) {
        u32x4* xr = (u32x4*)(XB + (size_t)t * D) + F.lane;
        const u32x4* y0 = (const u32x4*)(YK + (size_t)(2 * t) * D) + F.lane; const u32x4* y1 = (const u32x4*)(YK + (size_t)(2 * t + 1) * D) + F.lane;
        float v[2][8]; float s = 0.f; const float ga = GATES[2 * t], gb = GATES[2 * t + 1];
#pragma unroll
        for (int j = 0; j < 2; ++j) { const u32x4 a = xr[64 * j], b = y0[64 * j], c = y1[64 * j];
#pragma unroll
            for (int i = 0; i < 4; ++i) { v[j][2 * i] = bflo(a[i]) + ga * bflo(b[i]) + gb * bflo(c[i]); v[j][2 * i + 1] = bfhi(a[i]) + ga * bfhi(b[i]) + gb * bfhi(c[i]); s += v[j][2 * i] * v[j][2 * i] + v[j][2 * i + 1] * v[j][2 * i + 1]; } }
        s = wave_sum(s);
        const float rstd = rsqrtf(s * (1.0f / D) + EPS);
        if (gfinal) {
#pragma unroll
            for (int j = 0; j < 2; ++j) { const int c0 = 8 * (F.lane + 64 * j); const f32x4 g0 = gf[j][0], g1 = gf[j][1];
                f32x4 o0, o1;
#pragma unroll
                for (int i = 0; i < 4; ++i) { o0[i] = v[j][i] * rstd * g0[i]; o1[i] = v[j][4 + i] * rstd * g1[i]; }
                *(f32x4*)(out + (size_t)t * D + c0) = o0; *(f32x4*)(out + (size_t)t * D + c0 + 4) = o1; }
        } else {
            if (F.lane == 0) RSTD[t] = rstd;
#pragma unroll
            for (int j = 0; j < 2; ++j) { u32x4 w; w.x = cvt_pk_bf16(v[j][0], v[j][1]); w.y = cvt_pk_bf16(v[j][2], v[j][3]); w.z = cvt_pk_bf16(v[j][4], v[j][5]); w.w = cvt_pk_bf16(v[j][6], v[j][7]); xr[64 * j] = w; }
        }
    }
}

__device__ __forceinline__ void moe_setup(Frame& F, int l) {
    __syncthreads();
    if (F.tid < 64) {
        const int e = F.tid & 31;
        const unsigned c = __hip_atomic_load(F.ctl + CW_CNT + (l * NE + e) * 64, __ATOMIC_RELAXED, __HIP_MEMORY_SCOPE_AGENT);
        const unsigned tl = (c + 255u) / 256u;
        unsigned inc = tl;
#pragma unroll
        for (int o = 1; o < 32; o <<= 1) { const unsigned v = (unsigned)__builtin_amdgcn_ds_bpermute(((F.tid - o) & 63) << 2, (int)inc); if (e >= o) inc += v; }
        if (F.tid < 32) { F.MISC[64 + e] = c; F.MISC[16 + e] = inc - tl; if (e == 31) F.MISC[16 + NE] = inc; }
    }
    __syncthreads();
}

constexpr int N_PHASES = 1 + 7 * DEPTH;
__global__ void __launch_bounds__(NWAVES * 64, 2) mk_fwd(Args args) {
    extern __shared__ __attribute__((aligned(16))) unsigned char lds[];
    Frame F;
    F.lds = (LAS unsigned char*)lds; F.MISC = (volatile LAS unsigned*)(F.lds + MISC_OFF);
    F.wave = __builtin_amdgcn_readfirstlane((int)threadIdx.x >> 6); F.lane = lane_id(); F.tid = F.wave * 64 + F.lane;
    F.G = gridDim.x; { const int bx = blockIdx.x; F.vcu = (F.G % 8 == 0) ? (bx % 8) * (F.G / 8) + bx / 8 : bx; }
    F.ws = args.ws; F.ctl = (unsigned*)(args.ws + WS_CTL);
    for (int u = F.tid; u < 512; u += NWAVES * 64) F.MISC[u] = 0u;
    __syncthreads();
    if (F.tid == 0) {
        volatile LAS unsigned long long* pt = (volatile LAS unsigned long long*)(F.MISC + 128);
#define PT_(i) pt[i] = (unsigned long long)(uintptr_t)args.in[i];
        PT_(0) PT_(1) PT_(2) PT_(3) PT_(4) PT_(5) PT_(6) PT_(7) PT_(8) PT_(9) PT_(10) PT_(11) PT_(12) PT_(13) PT_(14) PT_(15) PT_(16)
#undef PT_
        pt[17] = (unsigned long long)(uintptr_t)args.out;
    }
    __syncthreads();
#if MK_ONE_LAUNCH
    XcdBarrier bar = xcd_barrier_post(F.ctl + CW_BAR, F.MISC + 0, F.tid);
#define GRID_BAR() xcd_barrier(bar, F.wave)
#else
#define GRID_BAR() do {} while (0)
#endif
    const int lo = args.ph_lo, hi = args.ph_hi;
#define IN(k) (lo <= (k) && (k) < hi)
#define SEAM(k) do { if (IN(k) && IN((k) + 1)) GRID_BAR(); } while (0)
    if (IN(0)) { relaunder(F); phase_prologue(F); SEAM(0); }
    for (int l = 0; l < DEPTH; ++l) {
        const int p = 1 + 7 * l;
        if (IN(p)) { relaunder(F);
            { const int ng = gemm_cus((T / 256) * 9, F.G); unsigned* ctr = F.ctl + CW_CONV + (l * 3 + 0) * 64;
              DenseSched<13> S{F.ws, l, ng, F.bx}; EpiG1 E{F.ws};
              const unsigned pk = pg8::gemm_phase<EpiG1, DenseSched<13>, false, true>(F.lds, F.MISC + 256, D, S, E, F.wave, ctr);
              relaunder(F);
              convert_work(F, ctr, cv_start(l, 0), cv_end(l, 0), F.bx >= ng, pk); }
            SEAM(p);
        }
        if (IN(p + 1)) { relaunder(F); phase_mixer(F, in_ptr(F, 3) + l * NH, in_ptr(F, 4) + (size_t)l * 3 * CW); SEAM(p + 1); }
        if (IN(p + 2)) { relaunder(F);
            DenseSched<2> S{F.ws, l, F.G, F.bx};
            EpiResid E{F.ws};
            pg8::gemm_phase<EpiResid, DenseSched<2>, false, true>(F.lds, F.MISC + 256, D, S, E, F.wave);
            relaunder(F); router_stage(F, l);
            SEAM(p + 2);
        }
        if (IN(p + 3)) { relaunder(F); if (!IN(p + 2)) router_stage(F, l); phase_router(F, l, in_ptr(F, 10) + l * NG, in_ptr(F, 12) + l * NE); SEAM(p + 3); }
        if (IN(p + 4)) { relaunder(F);
            moe_setup(F, l);
            const int ng = gemm_cus((int)F.MISC[16 + NE] * 4, F.G); unsigned* ctr = F.ctl + CW_CONV + (l * 3 + 1) * 64;
            MoeSched<true> S{F.ws, l, F.MISC, ng, F.bx};
            EpiAct E{S};
            const unsigned pk = pg8::gemm_phase<EpiAct, MoeSched<true>, true, true>(F.lds, F.MISC + 256, D, S, E, F.wave, ctr);
            relaunder(F);
            convert_work(F, ctr, cv_start(l, 1), cv_end(l, 1), F.bx >= ng, pk);
            SEAM(p + 4);
        }
        if (IN(p + 5)) { relaunder(F);
            const int ng = gemm_cus((int)F.MISC[16 + NE] * 4, F.G); unsigned* ctr = F.ctl + CW_CONV + (l * 3 + 2) * 64;
            MoeSched<false> S{F.ws, l, F.MISC, ng, F.bx};
            EpiDown E{S};
            const unsigned pk = pg8::gemm_phase<EpiDown, MoeSched<false>, false, true>(F.lds, F.MISC + 256, DE, S, E, F.wave, ctr);
            relaunder(F);
            convert_work(F, ctr, cv_start(l, 2), cv_end(l, 2), F.bx >= ng, pk);
            SEAM(p + 5);
        }
        if (IN(p + 6)) { relaunder(F); phase_combine(F, l == DEPTH - 1 ? in_ptr(F, 16) : nullptr, (float*)in_ptr(F, 17)); if (l < DEPTH - 1) SEAM(p + 6); }
    }
}

extern "C" void kernel_launch(void* const* d_in, const int* in_sizes, int n_in, void* d_out, int out_size, void* d_ws, size_t ws_size, hipStream_t stream) {
    static int grid = 0;
    if (grid == 0) {
        if (n_in != 17 || ws_size < WS_END) { fprintf(stderr, "kernel_launch: bad inputs (n_in %d, ws %zu)\n", n_in, ws_size); grid = -1; return; }
        int dev = 0, cus = 0, per_cu = 0;
        if (hipGetDevice(&dev) != hipSuccess || hipDeviceGetAttribute(&cus, hipDeviceAttributeMultiprocessorCount, dev) != hipSuccess) { grid = -1; return; }
        if (hipFuncSetAttribute((const void*)mk_fwd, hipFuncAttributeMaxDynamicSharedMemorySize, LDS_BYTES) != hipSuccess) { fprintf(stderr, "kernel_launch: hipFuncSetAttribute failed\n"); grid = -1; return; }
        if (hipOccupancyMaxActiveBlocksPerMultiprocessor(&per_cu, (const void*)mk_fwd, NWAVES * 64, LDS_BYTES) != hipSuccess || per_cu < 1) { fprintf(stderr, "kernel_launch: occupancy query says %d\n", per_cu); per_cu = 1; }
        (void)hipGetLastError();
        grid = cus;
    }
    if (grid < 0) return;
    (void)hipMemsetAsync((char*)d_ws + WS_CTL, 0, CTL_ZERO_BYTES, stream);
    Args a; memset(&a, 0, sizeof(a));
    for (int i = 0; i < 17; ++i) a.in[i] = (const float*)d_in[i];
    a.out = (float*)d_out; a.ws = (unsigned char*)d_ws;
#if MK_ONE_LAUNCH
    a.ph_lo = 0; a.ph_hi = N_PHASES;
    hipLaunchKernelGGL(mk_fwd, dim3(grid), dim3(NWAVES * 64), LDS_BYTES, stream, a);
#else
    for (int p = 0; p < N_PHASES; ++p) { a.ph_lo = p; a.ph_hi = p + 1; hipLaunchKernelGGL(mk_fwd, dim3(grid), dim3(NWAVES * 64), LDS_BYTES, stream, a); }
#endif
}
```

```cpp
#include <hip/hip_runtime.h>
#include <cstdio>
#include <cstdint>
#include <cstring>

#ifndef MK_ONE_LAUNCH
#define MK_ONE_LAUNCH 1
#endif

constexpr int D = 1024, BATCH = 4, SEQ = 8192, T = BATCH * SEQ, DEPTH = 4;
constexpr int NH = 8, HD = 64, AW = 512, CW = 512, INW = 2304;
constexpr int C_Q = 0, C_K = 512, C_V = 640, C_B = 768, C_C = 1280, C_U = 1792;
constexpr int PW = 1792, P_CU = 1280;
constexpr int NE = 32, NG = 4, DE = 512;
constexpr int WIN = 128;
constexpr float EPS = 1e-6f;
constexpr float QSCALE = 0.125f * 1.4426950408889634f;
constexpr float LOG2E = 1.4426950408889634f;
constexpr int LCAP = T;
constexpr int MAXSLOTS = 2 * T + NE * 256;

#define LAS __attribute__((address_space(3)))
#define GAS __attribute__((address_space(1)))
typedef unsigned short bf16_t;
typedef short bf16x8 __attribute__((ext_vector_type(8)));
typedef float f32x4 __attribute__((ext_vector_type(4)));
typedef unsigned u32x4 __attribute__((ext_vector_type(4)));
typedef unsigned u32x2 __attribute__((ext_vector_type(2)));

constexpr size_t MiB = 1u << 20;
constexpr size_t WS_CTL = 0, CTL_ZERO_BYTES = 128 * 1024;
constexpr size_t WS_CS = 1 * MiB;
constexpr size_t WS_RSTD = 2 * MiB;
constexpr size_t WS_SS = 3 * MiB;
constexpr size_t WS_GATES = 5 * MiB;
constexpr size_t WS_RSA = 5 * MiB + 512 * 1024;
constexpr size_t WS_LISTS = 6 * MiB;
constexpr size_t WS_WR = 10 * MiB;
constexpr size_t WS_WIN = 12 * MiB;
constexpr size_t WS_WOUT = 30 * MiB;
constexpr size_t WS_WGU = 40 * MiB;
constexpr size_t WS_WDN = 296 * MiB;
constexpr size_t WS_XB = 424 * MiB;
constexpr size_t WS_PROJ = 488 * MiB;
constexpr size_t WS_Y = 632 * MiB;
constexpr size_t WS_ACT = 696 * MiB;
constexpr size_t WS_YK = 768 * MiB;
constexpr size_t WS_DUMMY = 896 * MiB;
constexpr size_t WS_END = 897 * MiB;
constexpr int CW_BAR = 4096;
constexpr int CW_CONV = 8192;
constexpr int CW_CNT = 16384;

constexpr int RING_BYTES = 131072;
constexpr int MISC_OFF = RING_BYTES;
constexpr int LDS_BYTES = 147456;

__device__ __forceinline__ float bf2f(unsigned short b) { return __uint_as_float((unsigned)b << 16); }
__device__ __forceinline__ float bflo(unsigned w) { return __uint_as_float(w << 16); }
__device__ __forceinline__ float bfhi(unsigned w) { return __uint_as_float(w & 0xffff0000u); }
typedef float f32x2_t __attribute__((ext_vector_type(2)));
typedef __bf16 bf16x2_t __attribute__((ext_vector_type(2)));
__device__ __forceinline__ unsigned cvt_pk_bf16(float lo, float hi) { const f32x2_t v = {lo, hi}; const bf16x2_t b = __builtin_convertvector(v, bf16x2_t); return __builtin_bit_cast(unsigned, b); }
__device__ __forceinline__ float wave_sum(float v) {
#define WS_DPP(x, ctrl) __uint_as_float((unsigned)__builtin_amdgcn_update_dpp(0, (int)__float_as_uint(x), ctrl, 0xf, 0xf, false))
    v += WS_DPP(v, 0xB1); v += WS_DPP(v, 0x4E); v += WS_DPP(v, 0x124); v += WS_DPP(v, 0x128);
#undef WS_DPP
    { auto rr = __builtin_amdgcn_permlane16_swap(__float_as_uint(v), __float_as_uint(v), false, false); v = __uint_as_float(rr[0]) + __uint_as_float(rr[1]); }
    { auto rr = __builtin_amdgcn_permlane32_swap(__float_as_uint(v), __float_as_uint(v), false, false); v = __uint_as_float(rr[0]) + __uint_as_float(rr[1]); }
    return v;
}
__device__ __forceinline__ float xrow_sum(float v) { auto rr = __builtin_amdgcn_permlane16_swap(__float_as_uint(v), __float_as_uint(v), false, false); return __uint_as_float(rr[0]) + __uint_as_float(rr[1]); }
__device__ __forceinline__ float xhalf_other(float v, bool upper) { auto rr = __builtin_amdgcn_permlane32_swap(__float_as_uint(v), __float_as_uint(v), false, false); return __uint_as_float(upper ? rr[0] : rr[1]); }
__device__ __forceinline__ int lane_id() { int r; asm volatile("v_mbcnt_lo_u32_b32 %0, -1, 0\n\tv_mbcnt_hi_u32_b32 %0, -1, %0" : "=&v"(r)); return r; }
#define LDS_WAIT() asm volatile("s_waitcnt lgkmcnt(0)" ::: "memory")
#define VM_WAIT() asm volatile("s_waitcnt vmcnt(0)" ::: "memory")

namespace pg8 {
constexpr int BM = 256, BK = 64, HALF = 128, HTB = HALF * BK * 2, STAGE_BYTES = 8 * HTB, NXCD = 8, WGM = 8;
__host__ __device__ __forceinline__ int lds_byte(int r, int c) { const int st = (r >> 4) * 2 + (c >> 5), rr = r & 15, cc = c & 31, ob = rr * 64 + cc * 2; return st * 1024 + (ob ^ (((ob >> 9) & 1) << 5)); }
__host__ __device__ __forceinline__ void stage_rc(int b, int& R, int& C) { const int st = b / 1024, sb = b % 1024, swz = sb ^ (((sb >> 9) & 1) << 5); R = (st >> 1) * 16 + swz / 64; C = (st & 1) * 32 + (swz % 64) / 2; }
__host__ __device__ __forceinline__ int perm32(int rho) { const int n = rho >> 4, i = rho & 15; return 8 * (i >> 2) + 4 * n + (i & 3); }

struct Unit { int pm, pn, e, lt, nvalid; };

__device__ __forceinline__ bool tile_order(int L, int nM, int nN, int& pm, int& pn) {
    const int nwg = nM * nN; if (L >= nwg) return false;
    int wgid = L; { const int q = nwg / NXCD, r = nwg % NXCD, xcd = wgid % NXCD, off = wgid / NXCD; wgid = (xcd < r ? xcd * (q + 1) : r * (q + 1) + (xcd - r) * q) + off; }
    const int nig = WGM * nN, gid = wgid / nig, fm = gid * WGM, gsz = (nM - fm) < WGM ? (nM - fm) : WGM;
    pm = fm + ((wgid % nig) % gsz); pn = (wgid % nig) / gsz; return true;
}

template <class Epi, class Sched, bool GATHER, bool TABLE>
__device__ __forceinline__ unsigned gemm_phase(LAS unsigned char* lds, volatile LAS unsigned* tab, const int K, const Sched& S, const Epi& E, const int wave, unsigned* peek = nullptr) {
    int tid = wave * 64 + lane_id(); asm volatile("" : "+v"(tid));
    const int wid = wave, lane = tid & 63, wr = wid >> 2, wc = wid & 3, fr = lane & 15, fq = lane >> 4;
    const int nt = K / BK;
    constexpr int NST = Epi::NSTORE;
    unsigned voffB[2][2], cvo[2][2];
    {   int RR[2], CC[2];
#pragma unroll
        for (int i = 0; i < 2; ++i) { stage_rc(tid * 16 + i * 8192, RR[i], CC[i]); const int Rb = (RR[i] & ~31) + perm32(RR[i] & 31);
            voffB[0][i] = (unsigned)((64 * (RR[i] >> 5) + perm32(RR[i] & 31)) * K + CC[i]) * 2u; voffB[1][i] = voffB[0][i] + (unsigned)(32 * K * 2); (void)Rb;
            cvo[0][i] = (unsigned)(RR[i] * K + CC[i]) * 2u; cvo[1][i] = (unsigned)((RR[i] + HALF) * K + CC[i]) * 2u; } }
#define PG8_GATHER_VO(dst, tbl) do { int tid2_ = tid; asm volatile("" : "+v"(tid2_)); _Pragma("unroll") for (int i_ = 0; i_ < 2; ++i_) { int R_, C_; stage_rc(tid2_ * 16 + i_ * 8192, R_, C_); \
        _Pragma("unroll") for (int h_ = 0; h_ < 2; ++h_) dst[h_][i_] = (((tbl)[h_ * HALF + R_] & 0xfffeu) << 10) + (unsigned)C_ * 2u; } } while (0)
    const size_t kstep = (size_t)(BK * 2);
    const size_t hstep = (size_t)HALF * K * 2;
    const unsigned ldsw = (unsigned)wid * 1024u;
    const unsigned ldsbase = (unsigned)__builtin_amdgcn_readfirstlane((int)((unsigned)(uintptr_t)lds + ldsw));
    const int aoff = lds_byte(wr * 64 + fr, fq * 8), boff = lds_byte(wc * 32 + fr, fq * 8);
#define PG8_SA(b, h) (((b) * 2 + (h)) * HTB)
#define PG8_SB(b, h) ((4 + (b) * 2 + (h)) * HTB)
#define PG8_GLDS(gbase, voff32, ldsdst) do { unsigned keep_; asm volatile("s_mov_b32 %0, m0\n\ts_mov_b32 m0, %3\n\ts_nop 4\n\tglobal_load_lds_dwordx4 %1, %2\n\ts_mov_b32 m0, %0" \
        : "=&s"(keep_) : "v"(voff32), "s"(gbase), "s"(ldsdst) : "memory"); } while (0)
#define PG8_STAGE(bufoff, gbase, voff) do { _Pragma("unroll") for (int _i = 0; _i < 2; ++_i) \
        PG8_GLDS((const char*)(gbase), (voff)[_i], ldsbase + (unsigned)((bufoff) + _i * 8192)); } while (0)
#define PG8_LDA(dst, b, h) do { _Pragma("unroll") for (int m = 0; m < 4; ++m) _Pragma("unroll") for (int k = 0; k < 2; ++k) dst[m][k] = *(const LAS bf16x8*)(lds + PG8_SA(b, h) + aoff + m * 2048 + k * 1024); } while (0)
#define PG8_LDB(dst, b, h) do { _Pragma("unroll") for (int n = 0; n < 2; ++n) _Pragma("unroll") for (int k = 0; k < 2; ++k) dst[n][k] = *(const LAS bf16x8*)(lds + PG8_SB(b, h) + boff + n * 2048 + k * 1024); } while (0)
#define PG8_MMA(ai, bj, At, Bt) do { __builtin_amdgcn_s_setprio(1); _Pragma("unroll") for (int m = 0; m < 4; ++m) _Pragma("unroll") for (int n = 0; n < 2; ++n) _Pragma("unroll") for (int k = 0; k < 2; ++k) \
        acc[ai][bj][m][n] = __builtin_amdgcn_mfma_f32_16x16x32_bf16(Bt[n][k], At[m][k], acc[ai][bj][m][n], 0, 0, 0); __builtin_amdgcn_s_setprio(0); } while (0)
#define PG8_WAIT_V(n) asm volatile("s_waitcnt vmcnt(" #n ")" ::: "memory")
#define PG8_WAIT_VF(n) do { if (fresh) asm volatile("s_waitcnt vmcnt(%0)" :: "n"((n) + NST) : "memory"); else asm volatile("s_waitcnt vmcnt(8)" ::: "memory"); } while (0)
#define PG8_WAIT_L(n) asm volatile("s_waitcnt lgkmcnt(" #n ")" ::: "memory")
#define PG8_BAR __builtin_amdgcn_s_barrier()
#define PG8_SCHED __builtin_amdgcn_sched_barrier(0)
    Unit cur, nxt; int ui = 0;
    unsigned pk = 0u;
    if (!S.next(0, cur)) return 0u;
    f32x4 acc[2][2][4][2];
#pragma unroll
    for (int a = 0; a < 2; ++a)
#pragma unroll
        for (int b = 0; b < 2; ++b)
#pragma unroll
            for (int m = 0; m < 4; ++m)
#pragma unroll
                for (int n = 0; n < 2; ++n) acc[a][b][m][n] = (f32x4){0.f, 0.f, 0.f, 0.f};
    bf16x8 At[4][2], B0[2][2], B1[2][2];
    const char* cA = S.a_ptr(cur); const char* cB = S.b_ptr(cur);
    bool has_next = S.next(1, nxt);
    unsigned rinfo = 0u, rinfo0 = 0u;
    PG8_STAGE(PG8_SB(0, 0), cB, voffB[0]); PG8_STAGE(PG8_SB(0, 1), cB, voffB[1]);
    if constexpr (TABLE) {
        if (tid < 256) { rinfo0 = S.row_info(cur, tid); if (has_next) rinfo = S.row_info(nxt, tid); }
        if constexpr (GATHER) {
            if (tid < 256) tab[tid] = rinfo0;
            asm volatile("s_waitcnt vmcnt(0) lgkmcnt(0)" ::: "memory"); __builtin_amdgcn_s_barrier(); asm volatile("" ::: "memory");
            PG8_GATHER_VO(cvo, tab);
        }
    }
    int tb = 0;
    PG8_STAGE(PG8_SA(0, 0), cA, cvo[0]); PG8_STAGE(PG8_SA(0, 1), cA, cvo[1]);
    if (wr == 1) PG8_BAR;
    PG8_WAIT_V(2); PG8_BAR;
    if constexpr (TABLE && !GATHER) { if (tid < 256) tab[tid] = rinfo0; }
    PG8_STAGE(PG8_SB(1, 0), cB + kstep, voffB[0]); PG8_STAGE(PG8_SA(1, 0), cA + kstep, cvo[0]); PG8_STAGE(PG8_SB(1, 1), cB + kstep, voffB[1]);
    PG8_WAIT_V(6); PG8_BAR;
    for (;;) {
        const char* nA = has_next ? S.a_ptr(nxt) : cA; const char* nB = has_next ? S.b_ptr(nxt) : cB;
        Unit nn; const bool has_nn = has_next && S.next(ui + 2, nn);
        if (peek != nullptr && !has_next && tid == 0) pk = __hip_atomic_load(peek, __ATOMIC_RELAXED, __HIP_MEMORY_SCOPE_AGENT);
        if constexpr (TABLE) {
            { int t2 = tid; asm volatile("" : "+v"(t2));
              if (has_next) { if (t2 < 256) tab[(tb == 2 ? 0 : tb + 1) * 256 + t2] = rinfo; }
              if (has_nn) { if (t2 < 256) rinfo = S.row_info(nn, t2); } }
        }
        for (int t = 0; t < nt; t += 2) {
            const bool last = (t == nt - 2);
            const bool fresh = (t == 0) && (ui > 0);
            const char* a1 = cA + (size_t)(t + 1) * kstep;
            const char* a2 = last ? nA : cA + (size_t)(t + 2) * kstep; const char* b2 = last ? nB : cB + (size_t)(t + 2) * kstep;
            const char* a3 = a2 + kstep; const char* b3 = b2 + kstep;
            unsigned vo2[2][2];
#pragma unroll
            for (int h = 0; h < 2; ++h)
#pragma unroll
                for (int i = 0; i < 2; ++i) vo2[h][i] = cvo[h][i];
            if constexpr (GATHER) { if (last && has_next) PG8_GATHER_VO(vo2, tab + (tb == 2 ? 0 : tb + 1) * 256); }
            PG8_LDB(B0, 0, 0); PG8_LDB(B1, 0, 1); PG8_SCHED; PG8_LDA(At, 0, 0); if (!fresh) PG8_STAGE(PG8_SA(1, 1), a1, cvo[1]);
            PG8_WAIT_VF(8); PG8_WAIT_L(0); PG8_BAR; PG8_MMA(0, 0, At, B0); PG8_MMA(0, 1, At, B1); PG8_BAR; PG8_SCHED;
            PG8_LDA(At, 0, 1); PG8_STAGE(PG8_SB(0, 0), b2, voffB[0]); PG8_STAGE(PG8_SB(0, 1), b2, voffB[1]); PG8_STAGE(PG8_SA(0, 0), a2, vo2[0]);
            PG8_WAIT_VF(14); PG8_WAIT_L(0); PG8_BAR; PG8_MMA(1, 0, At, B0); PG8_MMA(1, 1, At, B1); PG8_BAR; PG8_SCHED;
            PG8_LDB(B0, 1, 0); PG8_LDB(B1, 1, 1); PG8_SCHED; PG8_LDA(At, 1, 0); PG8_STAGE(PG8_SA(0, 1), a2, vo2[1]);
            PG8_WAIT_VF(10); PG8_WAIT_L(0); PG8_BAR; PG8_MMA(0, 0, At, B0); PG8_MMA(0, 1, At, B1); PG8_BAR; PG8_SCHED;
            PG8_LDA(At, 1, 1); PG8_STAGE(PG8_SB(1, 0), b3, voffB[0]); PG8_STAGE(PG8_SB(1, 1), b3, voffB[1]); PG8_STAGE(PG8_SA(1, 0), a3, vo2[0]);
            PG8_WAIT_VF(14); PG8_WAIT_L(0); PG8_BAR; PG8_MMA(1, 0, At, B0); PG8_MMA(1, 1, At, B1); PG8_BAR; PG8_SCHED;
            if (last) PG8_STAGE(PG8_SA(1, 1), a3, vo2[1]);
            if constexpr (Epi::MIDSCALE) {
                if ((t + 2) * BK == Epi::MIDK) {
#pragma unroll
                    for (int a = 0; a < 2; ++a)
#pragma unroll
                        for (int m = 0; m < 4; ++m) { const float rsc = __uint_as_float(tab[tb * 256 + a * 128 + wr * 64 + m * 16 + fr]);
#pragma unroll
                            for (int b = 0; b < 2; ++b)
#pragma unroll
                                for (int n = 0; n < 2; ++n) acc[a][b][m][n] *= rsc; }
                }
            }
        }
        if (wr == 0) PG8_BAR;
        { int fr_ = fr, fq_ = fq; asm volatile("" : "+v"(fr_), "+v"(fq_)); E(acc, cur, wr, wc, fr_, fq_, tab + tb * 256); }
        if (!has_next) break;
#pragma unroll
        for (int a = 0; a < 2; ++a)
#pragma unroll
            for (int b = 0; b < 2; ++b)
#pragma unroll
                for (int m = 0; m < 4; ++m)
#pragma unroll
                    for (int n = 0; n < 2; ++n) acc[a][b][m][n] = (f32x4){0.f, 0.f, 0.f, 0.f};
        cur = nxt; cA = nA; cB = nB; ++ui; tb = (tb == 2 ? 0 : tb + 1); nxt = nn; has_next = has_nn;
        if constexpr (GATHER) PG8_GATHER_VO(cvo, tab + tb * 256);
        if (wr == 1) PG8_BAR;
    }
    PG8_WAIT_V(0);
    PG8_BAR;
    return pk;
#undef PG8_GATHER_VO
#undef PG8_SA
#undef PG8_SB
#undef PG8_STAGE
#undef PG8_GLDS
#undef PG8_LDA
#undef PG8_LDB
#undef PG8_MMA
#undef PG8_WAIT_V
#undef PG8_WAIT_VF
#undef PG8_WAIT_L
#undef PG8_BAR
#undef PG8_SCHED
}
}

#define XB_TMO      128
#define XB_XCNT(j)  (256  + 64 * (j))
#define XB_XSUB(j)  (1280 + 64 * (j))
#define XB_XGEN(j)  (2304 + 64 * (j))
#define XB_TOP      3328
#define XB_TOPGEN   3392
#define XCD_BAR_WORDS 3456
#define XB_SPIN_CAP (1u << 18)
__device__ __forceinline__ unsigned xb_ld(unsigned* p)              { return __hip_atomic_load(p, __ATOMIC_RELAXED, __HIP_MEMORY_SCOPE_AGENT); }
__device__ __forceinline__ unsigned xb_add(unsigned* p, unsigned v) { return __hip_atomic_fetch_add(p, v, __ATOMIC_RELAXED, __HIP_MEMORY_SCOPE_AGENT); }
__device__ __forceinline__ unsigned xb_xcc_id() { return (unsigned)__builtin_amdgcn_s_getreg((3 << 11) | 20) & 0xFu; }
#define XB_SPIN(cond, bar) do { unsigned _sp = 0; while (cond) { __builtin_amdgcn_s_sleep(1); \
    if ((++_sp & 255u) == 0u) { if (xb_ld(&(bar)[XB_TMO])) break; if (_sp > XB_SPIN_CAP) { atomicAdd(&(bar)[XB_TMO], 1u); break; } } } } while (0)
struct XcdBarrier { unsigned* bar; unsigned x; volatile LAS unsigned* st; };
__device__ __forceinline__ XcdBarrier xcd_barrier_post(unsigned* bar, volatile LAS unsigned* st, int tid) {
    XcdBarrier b; b.bar = bar; b.x = xb_xcc_id(); b.st = st;
    if (tid == 0) (void)xb_add(&bar[XB_XCNT(b.x)], 1u);
    return b;
}
__device__ __forceinline__ void xcd_barrier_complete(unsigned* bar, unsigned x, unsigned& nloc, unsigned& nx) {
    const unsigned G = gridDim.x * gridDim.y * gridDim.z;
    unsigned sum, cnt, mine, sp = 0u;
    for (;;) {
        sum = 0u; cnt = 0u; mine = 0u;
#pragma unroll
        for (unsigned j = 0; j < 16; ++j) { const unsigned c = xb_ld(&bar[XB_XCNT(j)]); sum += c; cnt += (c > 0u) ? 1u : 0u; mine = (j == x) ? c : mine; }
        if (sum == G) break;
        __builtin_amdgcn_s_sleep(1);
        if ((++sp & 255u) == 0u) { if (xb_ld(&bar[XB_TMO])) break; if (sp > XB_SPIN_CAP) { atomicAdd(&bar[XB_TMO], 1u); break; } }
    }
    nloc = mine > 0u ? mine : 1u; nx = cnt > 0u ? cnt : 1u;
}
__device__ __forceinline__ void xcd_barrier(const XcdBarrier& b, int wave) {
    asm volatile("s_waitcnt vmcnt(0)" ::: "memory");
    __syncthreads();
    if (wave == 0 && lane_id() == 0) {
        unsigned* bar = b.bar;
        __builtin_amdgcn_s_waitcnt(0);
        unsigned nloc = b.st[0], nx = b.st[1];
        if (nloc == 0u) { xcd_barrier_complete(bar, b.x, nloc, nx); b.st[0] = nloc; b.st[1] = nx; }
        const unsigned old = xb_add(&bar[XB_XSUB(b.x)], 1u);
        const unsigned gen = old / nloc;
        if (old + 1u == (gen + 1u) * nloc) {
            __builtin_amdgcn_fence(__ATOMIC_RELEASE, "agent");
            asm volatile("s_waitcnt vmcnt(0)" ::: "memory");
            (void)xb_add(&bar[XB_TOP], 1u);
        }
        XB_SPIN(xb_ld(&bar[XB_TOP]) < (gen + 1u) * nx, bar);
        __builtin_amdgcn_fence(__ATOMIC_ACQUIRE, "agent");
        asm volatile("s_waitcnt vmcnt(0)" ::: "memory");
    }
    __syncthreads();
}

struct Args {
    const float* in[17]; float* out; unsigned char* ws; int ph_lo, ph_hi;
};
struct Frame {
    LAS unsigned char* lds; volatile LAS unsigned* MISC; unsigned* ctl;
    int tid, lane, wave, vcu, G, bx;
    unsigned char* ws;
};
constexpr int NWAVES = 8;
__device__ __forceinline__ void relaunder(Frame& F) {
    unsigned m = (unsigned)(uintptr_t)F.MISC, d = (unsigned)(uintptr_t)F.lds; asm volatile("" : "+s"(m), "+s"(d));
    F.MISC = (volatile LAS unsigned*)(uintptr_t)m; F.lds = (LAS unsigned char*)(uintptr_t)d;
    asm volatile("" : "+s"(F.wave), "+s"(F.vcu));
    F.bx = (int)blockIdx.x; asm volatile("" : "+s"(F.bx));
    F.lane = lane_id(); F.tid = F.wave * 64 + F.lane;
    asm volatile("" : "+v"(F.tid), "+v"(F.lane));
    unsigned long long w = (unsigned long long)(uintptr_t)F.ws; asm volatile("" : "+s"(w)); F.ws = (unsigned char*)(GAS unsigned char*)(uintptr_t)w;
}
__device__ __forceinline__ const float* in_ptr(const Frame& F, int i) {
    volatile LAS unsigned* p = F.MISC + 128 + 2 * i;
    const unsigned lo = __builtin_amdgcn_readfirstlane(p[0]), hi = __builtin_amdgcn_readfirstlane(p[1]);
    return (const float*)(const GAS float*)(uintptr_t)(((unsigned long long)hi << 32) | lo);
}

template <int WHICH>
struct DenseSched {
    unsigned char* ws; int l, G, c;
    static constexpr int nM = T / 256, nN = WHICH == 1 ? 5 : WHICH == 13 ? 9 : 4, pn0 = WHICH == 3 ? 5 : 0;
    __device__ __forceinline__ int total() const { return nM * nN; }
    __device__ __forceinline__ bool next(int i, pg8::Unit& u) const {
        int pm, pn; if (c >= G || !pg8::tile_order(i * G + c, nM, nN, pm, pn)) return false;
        u.pm = pm; u.pn = pn + pn0; u.e = 0; u.lt = 0; u.nvalid = 256; return true;
    }
    __device__ __forceinline__ const char* a_ptr(const pg8::Unit& u) const { return (const char*)(ws + (WHICH == 2 ? WS_Y : WS_XB)) + (size_t)u.pm * 256 * D * 2; }
    __device__ __forceinline__ const char* b_ptr(const pg8::Unit& u) const {
        return WHICH == 2 ? (const char*)(ws + WS_WOUT) + ((size_t)l * D + u.pn * 256) * D * 2 : (const char*)(ws + WS_WIN) + ((size_t)l * INW + u.pn * 256) * D * 2; }
    __device__ __forceinline__ unsigned row_info(const pg8::Unit& u, int r) const { return ((const unsigned*)(ws + (WHICH == 2 ? WS_RSA : WS_RSTD)))[u.pm * 256 + r]; }
};
template <bool UP>
struct MoeSched {
    unsigned char* ws; int l; volatile LAS unsigned* misc; int G, c;
    __device__ __forceinline__ int total() const { return (int)misc[16 + NE] * 4; }
    __device__ __forceinline__ bool next(int i, pg8::Unit& u) const {
        const int nM = __builtin_amdgcn_readfirstlane((int)misc[16 + NE]); int pm, pn; if (c >= G || !pg8::tile_order(i * G + c, nM, 4, pm, pn)) return false;
        int ln = lane_id(); asm volatile("" : "+v"(ln)); ln &= 31;
        const int e = __popcll(__ballot((int)misc[16 + ln] <= pm)) / (int)(64 / NE) - 1;
        u.pm = pm; u.pn = pn; u.e = e; u.lt = pm - __builtin_amdgcn_readfirstlane((int)misc[16 + e]); const int rem = __builtin_amdgcn_readfirstlane((int)misc[64 + e]) - u.lt * 256; u.nvalid = rem < 256 ? rem : 256;
        return true;
    }
    __device__ __forceinline__ const char* a_ptr(const pg8::Unit& u) const { return UP ? (const char*)(ws + WS_XB) : (const char*)(ws + WS_ACT) + (size_t)u.pm * 256 * DE * 2; }
    __device__ __forceinline__ const char* b_ptr(const pg8::Unit& u) const {
        return UP ? (const char*)(ws + WS_WGU) + ((size_t)(l * NE + u.e) * 1024 + u.pn * 256) * D * 2 : (const char*)(ws + WS_WDN) + ((size_t)(l * NE + u.e) * D + u.pn * 256) * DE * 2; }
    __device__ __forceinline__ unsigned row_info(const pg8::Unit& u, int r) const { return r < u.nvalid ? ((const unsigned*)(ws + WS_LISTS))[(size_t)u.e * LCAP + u.lt * 256 + r] : (UP ? 0u : 0xffffffffu); }
};

typedef f32x4 Acc[2][2][4][2];
__device__ __forceinline__ u32x4 pack8(const f32x4 a, const f32x4 b) { u32x4 w; w.x = cvt_pk_bf16(a[0], a[1]); w.y = cvt_pk_bf16(a[2], a[3]); w.z = cvt_pk_bf16(b[0], b[1]); w.w = cvt_pk_bf16(b[2], b[3]); return w; }

__device__ __forceinline__ u32x4 xchg8(const u32x4 v) { u32x4 r;
#pragma unroll
    for (int q = 0; q < 4; ++q) r[q] = (unsigned)__builtin_amdgcn_update_dpp(0, (int)v[q], 0x128, 0xf, 0xf, false);
    return r; }
__device__ __forceinline__ float xrow16(float v, bool odd) { auto rr = __builtin_amdgcn_permlane16_swap(__float_as_uint(v), __float_as_uint(v), false, false); return __uint_as_float(odd ? rr[0] : rr[1]); }
struct EpiProj { static constexpr bool MIDSCALE = false; static constexpr int NSTORE = 16;
    unsigned char* ws;
    __device__ __forceinline__ void operator()(const Acc& acc, const pg8::Unit& u, int wr, int wc, int fr, int fq, volatile LAS unsigned* tab) const {
        bf16_t* O = (bf16_t*)(ws + WS_PROJ); const float* cs = (const float*)(ws + WS_CS);
        const int row0 = u.pm * 256 + wr * 64 + fr;
        const int cw = u.pn * 256 + wc * 64;
        const bool rope_wave = cw < C_V;
        const bool ropel = rope_wave && fq < 2;
        const bool lo = fr < 8;
        const int colp = cw + (lo ? 0 : 32) + 8 * fq;
        f32x4 c[4][4];
#define EPROJ_LOADC(ai_, m_) do { if (ropel) { const f32x4* c4 = (const f32x4*)(cs + (size_t)((row0 + (ai_) * 128 + (m_) * 16) & (SEQ - 1)) * 16); \
            _Pragma("unroll") for (int q = 0; q < 4; ++q) c[m_][q] = c4[q]; } else { _Pragma("unroll") for (int q = 0; q < 4; ++q) c[m_][q] = (f32x4){1.f, 0.f, 1.f, 0.f}; } } while (0)
#pragma unroll
        for (int m = 0; m < 4; ++m) EPROJ_LOADC(0, m);
#pragma unroll
        for (int ai = 0; ai < 2; ++ai) {
            float r[4];
#pragma unroll
            for (int m = 0; m < 4; ++m) r[m] = __uint_as_float(tab[ai * 128 + wr * 64 + m * 16 + fr]);
#pragma unroll
            for (int m = 0; m < 4; ++m) {
                f32x4 v0 = acc[ai][0][m][0] * r[m], v1 = acc[ai][0][m][1] * r[m];
                if (rope_wave) {
                    f32x4 o0, o1;
#pragma unroll
                    for (int j = 0; j < 4; ++j) { o0[j] = xrow16(v0[j], (fq & 1) != 0); o1[j] = xrow16(v1[j], (fq & 1) != 0); }
                    const float sg = fq == 0 ? -1.f : 1.f;
                    v0[0] = v0[0] * c[m][0][0] + sg * o0[0] * c[m][0][1]; v0[1] = v0[1] * c[m][0][2] + sg * o0[1] * c[m][0][3];
                    v0[2] = v0[2] * c[m][1][0] + sg * o0[2] * c[m][1][1]; v0[3] = v0[3] * c[m][1][2] + sg * o0[3] * c[m][1][3];
                    v1[0] = v1[0] * c[m][2][0] + sg * o1[0] * c[m][2][1]; v1[1] = v1[1] * c[m][2][2] + sg * o1[1] * c[m][2][3];
                    v1[2] = v1[2] * c[m][3][0] + sg * o1[2] * c[m][3][1]; v1[3] = v1[3] * c[m][3][2] + sg * o1[3] * c[m][3][3];
                }
                if (ai == 0) EPROJ_LOADC(1, m);
                const u32x4 p0 = pack8(v0, v1), p1 = pack8(acc[ai][1][m][0] * r[m], acc[ai][1][m][1] * r[m]);
                const u32x4 rcv = xchg8(lo ? p1 : p0);
                bf16_t* rl = O + (size_t)(row0 + ai * 128 + m * 16 - (lo ? 0 : 8)) * PW + colp;
                *(u32x4*)rl = lo ? p0 : rcv;
                *(u32x4*)(rl + (size_t)8 * PW) = lo ? rcv : p1;
            }
        }
#undef EPROJ_LOADC
    }
};
struct EpiCu { static constexpr bool MIDSCALE = false; static constexpr int NSTORE = 8;
    unsigned char* ws;
    __device__ __forceinline__ void operator()(const Acc& acc, const pg8::Unit& u, int wr, int wc, int fr, int fq, volatile LAS unsigned* tab) const {
        bf16_t* O = (bf16_t*)(ws + WS_PROJ);
        const int row0 = u.pm * 256 + wr * 64 + fr;
        float r2[8];
#pragma unroll
        for (int i = 0; i < 8; ++i) { const float rs = __uint_as_float(tab[(i >> 2) * 128 + wr * 64 + (i & 3) * 16 + fr]); r2[i] = rs * rs; }
#pragma unroll
        for (int ai = 0; ai < 2; ++ai)
#pragma unroll
            for (int m = 0; m < 4; ++m) {
                const f32x4 p0 = acc[ai][0][m][0] * acc[ai][1][m][0] * r2[ai * 4 + m], p1 = acc[ai][0][m][1] * acc[ai][1][m][1] * r2[ai * 4 + m];
                *(u32x4*)(O + (size_t)(row0 + ai * 128 + m * 16) * PW + P_CU + (u.pn - 5) * 128 + wc * 32 + 8 * fq) = pack8(p0, p1);
            }
    }
};
struct EpiG1 { static constexpr bool MIDSCALE = false; static constexpr int NSTORE = 8;
    unsigned char* ws;
    __device__ __forceinline__ void operator()(const Acc& acc, const pg8::Unit& u, int wr, int wc, int fr, int fq, volatile LAS unsigned* tab) const {
        if (u.pn < 5) { EpiProj E{ws}; E(acc, u, wr, wc, fr, fq, tab); } else { EpiCu E{ws}; E(acc, u, wr, wc, fr, fq, tab); }
    }
};
struct EpiResid { static constexpr bool MIDSCALE = true; static constexpr int MIDK = AW; static constexpr int NSTORE = 24;
    unsigned char* ws;
    __device__ __forceinline__ void operator()(const Acc& acc, const pg8::Unit& u, int wr, int wc, int fr, int fq, volatile LAS unsigned* tab) const {
        bf16_t* XB = (bf16_t*)(ws + WS_XB); float* SS = (float*)(ws + WS_SS);
        const int row0 = u.pm * 256 + wr * 64 + fr;
        const bool lo = fr < 8;
        const int colp = u.pn * 256 + wc * 64 + (lo ? 0 : 32) + 8 * fq;
        u32x4 xa[2][4], xb2[2][4];
#pragma unroll
        for (int ai = 0; ai < 2; ++ai)
#pragma unroll
            for (int m = 0; m < 4; ++m) { const bf16_t* rl = XB + (size_t)(row0 + ai * 128 + m * 16 - (lo ? 0 : 8)) * D + colp; xa[ai][m] = *(const u32x4*)rl; xb2[ai][m] = *(const u32x4*)(rl + (size_t)8 * D); }
#pragma unroll
        for (int ai = 0; ai < 2; ++ai) {
#pragma unroll
            for (int m = 0; m < 4; ++m) {
                const int row = row0 + ai * 128 + m * 16;
                const u32x4 r0 = xchg8(xa[ai][m]), r1 = xchg8(xb2[ai][m]);
                const u32x4 x0 = lo ? xa[ai][m] : r1, x1 = lo ? r0 : xb2[ai][m];
                f32x4 v00 = acc[ai][0][m][0], v01 = acc[ai][0][m][1], v10 = acc[ai][1][m][0], v11 = acc[ai][1][m][1];
                v00[0] += bflo(x0.x); v00[1] += bfhi(x0.x); v00[2] += bflo(x0.y); v00[3] += bfhi(x0.y); v01[0] += bflo(x0.z); v01[1] += bfhi(x0.z); v01[2] += bflo(x0.w); v01[3] += bfhi(x0.w);
                v10[0] += bflo(x1.x); v10[1] += bfhi(x1.x); v10[2] += bflo(x1.y); v10[3] += bfhi(x1.y); v11[0] += bflo(x1.z); v11[1] += bfhi(x1.z); v11[2] += bflo(x1.w); v11[3] += bfhi(x1.w);
                float sq = 0.f;
#pragma unroll
                for (int j = 0; j < 4; ++j) sq += v00[j] * v00[j] + v01[j] * v01[j] + v10[j] * v10[j] + v11[j] * v11[j];
                sq = xrow_sum(sq); { auto rr = __builtin_amdgcn_permlane32_swap(__float_as_uint(sq), __float_as_uint(sq), false, false); sq = __uint_as_float(rr[0]) + __uint_as_float(rr[1]); }
                if (fq == 0) SS[(size_t)(u.pn * 4 + wc) * T + row] = sq;
                const u32x4 p0 = pack8(v00, v01), p1 = pack8(v10, v11);
                const u32x4 rcv = xchg8(lo ? p1 : p0);
                bf16_t* rl = XB + (size_t)(row - (lo ? 0 : 8)) * D + colp;
                *(u32x4*)rl = lo ? p0 : rcv;
                *(u32x4*)(rl + (size_t)8 * D) = lo ? rcv : p1;
            }
        }
    }
};
struct EpiAct { static constexpr bool MIDSCALE = false; static constexpr int NSTORE = 8;
    MoeSched<true> S;
    __device__ __forceinline__ void operator()(const Acc& acc, const pg8::Unit& u, int wr, int wc, int fr, int fq, volatile LAS unsigned* tab) const {
        bf16_t* ACT = (bf16_t*)(S.ws + WS_ACT);
        unsigned te[8];
#pragma unroll
        for (int i = 0; i < 8; ++i) te[i] = tab[(i >> 2) * 128 + wr * 64 + (i & 3) * 16 + fr];
#pragma unroll
        for (int ai = 0; ai < 2; ++ai)
#pragma unroll
            for (int m = 0; m < 4; ++m) {
                const int r = ai * 128 + wr * 64 + m * 16 + fr; const float rs = __uint_as_float(te[ai * 4 + m] & 0xffff0000u);
                f32x4 o[2];
#pragma unroll
                for (int n = 0; n < 2; ++n)
#pragma unroll
                    for (int j = 0; j < 4; ++j) { const float g = acc[ai][0][m][n][j] * rs, up = acc[ai][1][m][n][j] * rs; o[n][j] = g * __builtin_amdgcn_rcpf(1.0f + __builtin_amdgcn_exp2f(-g * LOG2E)) * up; }
                *(u32x4*)(ACT + (size_t)(u.pm * 256 + r) * DE + u.pn * 128 + wc * 32 + 8 * fq) = pack8(o[0], o[1]);
            }
    }
};
struct EpiDown { static constexpr bool MIDSCALE = false; static constexpr int NSTORE = 16;
    MoeSched<false> S;
    __device__ __forceinline__ void operator()(const Acc& acc, const pg8::Unit& u, int wr, int wc, int fr, int fq, volatile LAS unsigned* tab) const {
        unsigned char* YK = S.ws + WS_YK;
        const bool lo = fr < 8;
        const unsigned colb = (unsigned)(u.pn * 256 + wc * 64 + (lo ? 0 : 32) + 8 * fq) * 2u;
        unsigned te[8][2];
#pragma unroll
        for (int i = 0; i < 8; ++i) { te[i][0] = tab[(i >> 2) * 128 + wr * 64 + (i & 3) * 16 + (fr & 7)]; te[i][1] = tab[(i >> 2) * 128 + wr * 64 + (i & 3) * 16 + 8 + (fr & 7)]; }
#pragma unroll
        for (int ai = 0; ai < 2; ++ai)
#pragma unroll
            for (int m = 0; m < 4; ++m) {
                const unsigned q1 = te[ai * 4 + m][0], q2 = te[ai * 4 + m][1];
                const unsigned o1 = (q1 == 0xffffffffu ? (unsigned)(2 * T) : (q1 & 0xffffu)) * (unsigned)(D * 2) + colb, o2 = (q2 == 0xffffffffu ? (unsigned)(2 * T) : (q2 & 0xffffu)) * (unsigned)(D * 2) + colb;
                const u32x4 p0 = pack8(acc[ai][0][m][0], acc[ai][0][m][1]), p1 = pack8(acc[ai][1][m][0], acc[ai][1][m][1]);
                const u32x4 r0 = xchg8(p0), r1 = xchg8(p1);
                *(u32x4*)(YK + o1) = lo ? p0 : r1;
                *(u32x4*)(YK + o2) = lo ? r0 : p1;
                __builtin_amdgcn_sched_barrier(0);
            }
    }
};

__device__ __forceinline__ void p0_tile(const float* W, int ldw, int k0, int n0, bf16_t* WT, int Kt, int dst_row0, const float* gk, float cs, LAS unsigned char* scr, int lane, bool split = false) {
    const int r0 = lane >> 4, c = lane & 15;
    const float* src = W + (size_t)(k0 + 16 * r0) * ldw + n0 + 4 * c;
    f32x4 v[16];
#pragma unroll
    for (int i = 0; i < 16; ++i) v[i] = __builtin_nontemporal_load((const f32x4*)(src + (size_t)i * ldw));
    float g[16];
    if (gk) {
#pragma unroll
        for (int q = 0; q < 4; ++q) { const f32x4 t = *(const f32x4*)(gk + k0 + 16 * r0 + 4 * q); g[4 * q] = t[0] * cs; g[4 * q + 1] = t[1] * cs; g[4 * q + 2] = t[2] * cs; g[4 * q + 3] = t[3] * cs; }
    } else {
#pragma unroll
        for (int i = 0; i < 16; ++i) g[i] = cs;
    }
#pragma unroll
    for (int j = 0; j < 4; ++j) {
        u32x4 lo, hi2;
        lo.x = cvt_pk_bf16(v[0][j] * g[0], v[1][j] * g[1]); lo.y = cvt_pk_bf16(v[2][j] * g[2], v[3][j] * g[3]); lo.z = cvt_pk_bf16(v[4][j] * g[4], v[5][j] * g[5]); lo.w = cvt_pk_bf16(v[6][j] * g[6], v[7][j] * g[7]);
        hi2.x = cvt_pk_bf16(v[8][j] * g[8], v[9][j] * g[9]); hi2.y = cvt_pk_bf16(v[10][j] * g[10], v[11][j] * g[11]); hi2.z = cvt_pk_bf16(v[12][j] * g[12], v[13][j] * g[13]); hi2.w = cvt_pk_bf16(v[14][j] * g[14], v[15][j] * g[15]);
        const int n = 4 * c + j, sw = c & 7;
        *(LAS u32x4*)(scr + n * 128 + (((2 * r0) ^ sw) << 4)) = lo;
        *(LAS u32x4*)(scr + n * 128 + (((2 * r0 + 1) ^ sw) << 4)) = hi2;
    }
    LDS_WAIT(); asm volatile("" ::: "memory");
    const int ch = lane & 7;
#pragma unroll
    for (int i = 0; i < 8; ++i) { const int n = 8 * i + (lane >> 3);
        const u32x4 o = *(const LAS u32x4*)(scr + n * 128 + ((ch ^ ((n >> 2) & 7)) << 4));
        *(u32x4*)(WT + (size_t)(dst_row0 + n + (split ? 32 * (n >> 5) : 0)) * Kt + k0 + 8 * ch) = o; }
    LDS_WAIT(); asm volatile("" ::: "memory");
}
constexpr int CV_IN = 16 * 36, CV_OUT = 16 * 16, CV_G = NE * 128, CV_U = NE * 128, CV_D = NE * 128, CV_L = CV_IN + CV_OUT + CV_G + CV_U + CV_D;
__device__ __forceinline__ void convert_item(Frame& F, int l, int r, LAS unsigned char* scr) {
    unsigned char* ws = F.ws;
    if (r < CV_IN) { const int kb = r / 36, nb = r % 36;
        const int n0 = nb * 64;
        const int jc = n0 - C_C, ju = n0 - C_U;
        const int dst = n0 < C_C ? n0 : (n0 < C_U ? C_C + 256 * (jc / 128) + 2 * (jc % 128) : C_C + 256 * (ju / 128) + 2 * (ju % 128) + 32);
        p0_tile(in_ptr(F, 2) + (size_t)l * D * INW, INW, kb * 64, n0, (bf16_t*)(ws + WS_WIN) + (size_t)l * INW * D, D, dst, in_ptr(F, 1) + l * D, (n0 < C_K) ? QSCALE : 1.0f, scr, F.lane, n0 >= C_C); return; }
    r -= CV_IN;
    if (r < CV_OUT) { const int kb = r / 16, nb = r % 16; const int k0 = kb * 64;
        const float* gk = (k0 < AW) ? in_ptr(F, 5) + l * AW : in_ptr(F, 6) + l * CW - AW;
        p0_tile(in_ptr(F, 7) + (size_t)l * D * D, D, k0, nb * 64, (bf16_t*)(ws + WS_WOUT) + (size_t)l * D * D, D, nb * 64, gk, 1.0f, scr, F.lane); return; }
    r -= CV_OUT;
    if (r < CV_G + CV_U) { const int up = r >= CV_G; if (up) r -= CV_G; const int e = r / 128, q = r % 128, kb = q / 8, nb = q % 8; const int n0 = nb * 64;
        const float* W = in_ptr(F, up ? 14 : 13) + ((size_t)l * NE + e) * D * DE;
        p0_tile(W, DE, kb * 64, n0, (bf16_t*)(ws + WS_WGU) + ((size_t)l * NE + e) * 1024 * D, D, 256 * (n0 / 128) + 2 * (n0 % 128) + (up ? 32 : 0), in_ptr(F, 8) + l * D, 1.0f, scr, F.lane, true); return; }
    r -= CV_G + CV_U;
    { const int e = r / 128, q = r % 128, kb = q / 16, nb = q % 16;
      p0_tile(in_ptr(F, 15) + ((size_t)l * NE + e) * DE * D, D, kb * 64, nb * 64, (bf16_t*)(ws + WS_WDN) + ((size_t)l * NE + e) * D * DE, DE, nb * 64, nullptr, 1.0f, scr, F.lane); }
}
#ifndef CVX
#define CVX 4424
#define CVY 1344
#endif
#ifndef CV0
#define CV0 CVX
#endif
constexpr int CV_TOT = DEPTH * CV_L, CV_GUEND = CV_IN + CV_OUT + CV_G + CV_U;
static_assert(CVX >= CV_IN + CV_OUT && CVX <= CV_GUEND && CVY >= 0 && CVY <= CVX && CV0 >= CV_IN + CV_OUT && CV0 <= CV_GUEND, "conversion schedule");
__device__ __forceinline__ int cv_end(int l, int ph) { const int e = ph == 0 ? l * CV_L + CV_GUEND : ph == 1 ? (l + 1) * CV_L + CVY : (l + 1) * CV_L + CVX; return e < CV_TOT ? e : CV_TOT; }
__device__ __forceinline__ int cv_start(int l, int ph) { return ph == 0 ? (l == 0 ? CV0 : cv_end(l - 1, 2)) : cv_end(l, ph - 1); }
__device__ __forceinline__ int gemm_cus(int U, int G) { const int mx = (U + G - 1) / G; const int n = ((U + mx - 1) / mx + 7) & ~7; return n < G ? n : G; }
__device__ __forceinline__ void convert_work(Frame& F, unsigned* ctr, int start, int end, bool conv_cu, unsigned pk) {
    if (start >= end) return;
    const unsigned n = (unsigned)(end - start);
    volatile LAS unsigned* mb = F.MISC + 8;
    LAS unsigned char* scr = F.lds + F.wave * 16384;
    unsigned nxt = 0xffffffffu;
    if (F.tid == 0 && (conv_cu || pk < n)) nxt = __hip_atomic_fetch_add(ctr, 8u, __ATOMIC_RELAXED, __HIP_MEMORY_SCOPE_AGENT);
    for (;;) {
        if (F.tid == 0) mb[0] = nxt;
        __syncthreads();
        const unsigned base = mb[0];
        if (base >= n) break;
        if (F.tid == 0) nxt = __hip_atomic_fetch_add(ctr, 8u, __ATOMIC_RELAXED, __HIP_MEMORY_SCOPE_AGENT);
        const int it = start + (int)base + F.wave;
        if (it < end) convert_item(F, it / CV_L, it % CV_L, scr);
        __syncthreads();
    }
}
__device__ __forceinline__ void phase_prologue(Frame& F) {
    LAS unsigned char* scr = F.lds + F.wave * 16384;
    const int gw = F.vcu * NWAVES + F.wave, NGW = F.G * NWAVES;
    unsigned char* ws = F.ws;
    for (int it = gw; it < CV0; it += NGW) convert_item(F, it / CV_L, it % CV_L, scr);
    relaunder(F);
    {
        const int gt0 = F.vcu * 512 + F.tid, NGT0 = F.G * 512;
        for (int i = gt0; i < DEPTH * NE * D; i += NGT0) {
            const int l = i / (NE * D), e = (i / D) % NE, k = i % D;
            const float v = in_ptr(F, 11)[(size_t)l * D * NE + k * NE + e] * in_ptr(F, 8)[l * D + k];
            ((bf16_t*)(ws + WS_WR))[(size_t)l * 64 * D + (size_t)e * D + k] = (bf16_t)(cvt_pk_bf16(v, 0.f) & 0xffffu);
        }
    }
    const int gt = F.vcu * 512 + F.tid, NGT = F.G * 512;
    for (int i = gt; i < DEPTH * 32 * D; i += NGT) {
        const int l = i / (32 * D), rr = (i / D) % 32, k = i % D;
        float v = 0.f; if (rr < NG) v = in_ptr(F, 9)[(size_t)l * D * NG + k * NG + rr] * in_ptr(F, 8)[l * D + k];
        ((bf16_t*)(ws + WS_WR))[(size_t)l * 64 * D + (size_t)(32 + rr) * D + k] = (bf16_t)(cvt_pk_bf16(v, 0.f) & 0xffffu);
    }
    for (int i = gt; i < SEQ * 8; i += NGT) {
        const int pos = i >> 3, f = i & 7;
        const double ang = (double)pos * pow(500000.0, -(double)f / 8.0);
        ((float2*)(ws + WS_CS))[i] = make_float2((float)cos(ang), (float)sin(ang));
    }
    relaunder(F);
    const float* x = in_ptr(F, 0);
    for (int row = gw; row < T; row += NGW) {
        const f32x4* xr = (const f32x4*)(x + (size_t)row * D) + F.lane;
        f32x4 v[4]; float s = 0.f;
#pragma unroll
        for (int j = 0; j < 4; ++j) { v[j] = xr[64 * j]; s += v[j][0] * v[j][0] + v[j][1] * v[j][1] + v[j][2] * v[j][2] + v[j][3] * v[j][3]; }
        s = wave_sum(s);
        if (F.lane == 0) ((float*)(ws + WS_RSTD))[row] = rsqrtf(s * (1.0f / D) + EPS);
        u32x2* o = (u32x2*)((bf16_t*)(ws + WS_XB) + (size_t)row * D) + F.lane;
#pragma unroll
        for (int j = 0; j < 4; ++j) { u32x2 w; w.x = cvt_pk_bf16(v[j][0], v[j][1]); w.y = cvt_pk_bf16(v[j][2], v[j][3]); o[64 * j] = w; }
    }
}

typedef float f32x16 __attribute__((ext_vector_type(16)));
typedef short v4i16 __attribute__((ext_vector_type(4)));
constexpr int ATT_K_OFF = 0, ATT_V_OFF = 49152, ATT_STG_OFF = 98304;
constexpr int SSQ_WORD = 1024, RSQ_WORD = 2048;
__device__ __forceinline__ int crow(int r, int hi) { return (r & 3) + 8 * (r >> 2) + 4 * hi; }

__device__ __forceinline__ float xhalf_max(float v) { auto rr = __builtin_amdgcn_permlane32_swap(__float_as_uint(v), __float_as_uint(v), false, false); return fmaxf(__uint_as_float(rr[0]), __uint_as_float(rr[1])); }
__device__ __forceinline__ float xhalf_sum(float v) { auto rr = __builtin_amdgcn_permlane32_swap(__float_as_uint(v), __float_as_uint(v), false, false); return __uint_as_float(rr[0]) + __uint_as_float(rr[1]); }
template <int MASK>
__device__ __forceinline__ void attn_step(LAS unsigned char* lds, int kt, const bf16x8 (&qf)[4], const unsigned (&koff)[4], const unsigned (&vb)[2], int ql, int hi, float& m, float& l, f32x16 (&o)[2], f32x16& negm) {
    const LAS unsigned char* kb = lds + ATT_K_OFF + kt * 4096;
    const LAS unsigned char* vbase = lds + ATT_V_OFF + kt * 4096;
    bf16x8 kf[4];
#pragma unroll
    for (int ks = 0; ks < 4; ++ks) kf[ks] = *(const LAS bf16x8*)(kb + koff[ks]);
    f32x16 sacc = __builtin_amdgcn_mfma_f32_32x32x16_bf16(kf[0], qf[0], negm, 0, 0, 0);
#pragma unroll
    for (int ks = 1; ks < 4; ++ks) sacc = __builtin_amdgcn_mfma_f32_32x32x16_bf16(kf[ks], qf[ks], sacc, 0, 0, 0);
    v4i16 va[4], vc[4];
#pragma unroll
    for (int i = 0; i < 4; ++i) {
        va[i] = __builtin_amdgcn_ds_read_tr16_b64_v4i16((LAS v4i16*)(vbase + vb[i >> 1] + (i & 1) * 2048));
        vc[i] = __builtin_amdgcn_ds_read_tr16_b64_v4i16((LAS v4i16*)(vbase + vb[i >> 1] + (i & 1) * 2048 + 1024));
    }
    if (MASK == 1) {
#pragma unroll
        for (int r = 0; r < 16; ++r) if (crow(r, hi) < ql) sacc[r] = -1e30f;
    }
    if (MASK == 2) {
#pragma unroll
        for (int r = 0; r < 16; ++r) if (crow(r, hi) > ql) sacc[r] = -1e30f;
    }
    float mx = sacc[0];
#pragma unroll
    for (int r = 1; r < 16; ++r) mx = fmaxf(mx, sacc[r]);
    mx = xhalf_max(mx);
    if (!__all(mx <= 8.0f)) {
        asm volatile("" ::: "memory");
        const float d = fmaxf(mx, 0.f), alpha = __builtin_amdgcn_exp2f(-d);
        l *= alpha;
#pragma unroll
        for (int r = 0; r < 16; ++r) { o[0][r] *= alpha; o[1][r] *= alpha; sacc[r] -= d; negm[r] -= d; }
        m += d;
    }
    float ps = 0.f;
#pragma unroll
    for (int r = 0; r < 16; ++r) { sacc[r] = __builtin_amdgcn_exp2f(sacc[r]); ps += sacc[r]; }
    l += ps;
    bf16x8 pf[2];
#pragma unroll
    for (int s2 = 0; s2 < 2; ++s2) {
        u32x4 w; w.x = cvt_pk_bf16(sacc[8 * s2 + 0], sacc[8 * s2 + 1]); w.y = cvt_pk_bf16(sacc[8 * s2 + 2], sacc[8 * s2 + 3]); w.z = cvt_pk_bf16(sacc[8 * s2 + 4], sacc[8 * s2 + 5]); w.w = cvt_pk_bf16(sacc[8 * s2 + 6], sacc[8 * s2 + 7]);
        pf[s2] = __builtin_bit_cast(bf16x8, w);
    }
#pragma unroll
    for (int i = 0; i < 4; ++i) {
        const bf16x8 vf = (bf16x8){va[i][0], va[i][1], va[i][2], va[i][3], vc[i][0], vc[i][1], vc[i][2], vc[i][3]};
        o[i >> 1] = __builtin_amdgcn_mfma_f32_32x32x16_bf16(vf, pf[i & 1], o[i >> 1], 0, 0, 0);
    }
}

__device__ __forceinline__ void phase_mixer(Frame& F, const float* sink, const float* cw) {
    const bf16_t* P = (const bf16_t*)(F.ws + WS_PROJ);
    bf16_t* Y = (bf16_t*)(F.ws + WS_Y);
    const int tid = F.tid, lane = F.lane, w = F.wave;
    const int ql = lane & 31, hi = lane >> 5;
    LAS unsigned char* lds = F.lds;
    volatile LAS float* ssq = (volatile LAS float*)(F.MISC + SSQ_WORD);
    volatile LAS float* rsq = (volatile LAS float*)(F.MISC + RSQ_WORD);
    unsigned koff[4], vb[2];
#pragma unroll
    for (int ks = 0; ks < 4; ++ks) koff[ks] = (unsigned)(ql * 128 + (((2 * ks + hi) ^ ((ql >> 1) & 7)) << 4));
    { const int g = (lane >> 4) & 1, li = lane & 15, q = li >> 2, p = li & 3, sw = (q >> 1) & 1;
      vb[0] = (unsigned)((4 * hi + q) * 128 + 64 * sw + 32 * g + 8 * p); vb[1] = (unsigned)((4 * hi + q) * 128 + 64 * (1 - sw) + 32 * g + 8 * p); }
    for (int unit = F.vcu; unit < BATCH * (SEQ / 128); unit += F.G) {
        const int b = unit / (SEQ / 128), n = unit % (SEQ / 128);
        const size_t tok0 = (size_t)b * SEQ + (size_t)n * 128;
#pragma unroll 1
        for (int part = 0; part < 2; ++part) {
        if ((part == 0) != ((F.vcu & 1) != 0)) {
        u32x4 kv[6], vv[6];
#define ATT_LOAD_K(kvh_) do { _Pragma("unroll") for (int i = 0; i < 6; ++i) { const int idx = tid + 512 * i, key = idx >> 3, ch = idx & 7; \
            const int kpos = (n - 1) * 128 + key; const int kc = kpos < 0 ? 0 : (kpos >= SEQ ? SEQ - 1 : kpos); \
            kv[i] = *(const u32x4*)(P + ((size_t)b * SEQ + kc) * PW + (kvh_) * HD + ch * 8 + C_K); } } while (0)
#define ATT_LOAD_V(kvh_) do { _Pragma("unroll") for (int i = 0; i < 6; ++i) { const int idx = tid + 512 * i, key = idx >> 3, ch = idx & 7; \
            const int kpos = (n - 1) * 128 + key; const int kc = kpos < 0 ? 0 : (kpos >= SEQ ? SEQ - 1 : kpos); \
            vv[i] = *(const u32x4*)(P + ((size_t)b * SEQ + kc) * PW + (kvh_) * HD + ch * 8 + C_V); } } while (0)
        { int tid = F.tid; asm volatile("" : "+v"(tid)); ATT_LOAD_K(0); ATT_LOAD_V(0); }
#pragma unroll
        for (int kvh = 0; kvh < 2; ++kvh) {
            int tid = F.tid; asm volatile("" : "+v"(tid));
            if (kvh == 1) ATT_LOAD_V(1);
            __syncthreads();
            const int head = kvh * 4 + (w >> 1), qh = w & 1;
#pragma unroll
            for (int i = 0; i < 6; ++i) {
                const int idx = tid + 512 * i, key = idx >> 3, ch = idx & 7;
                const int kpos = (n - 1) * 128 + key; const bool ok = kpos >= 0 && kpos < SEQ;
                const u32x4 z = (u32x4){0u, 0u, 0u, 0u};
                *(LAS u32x4*)(lds + ATT_K_OFF + key * 128 + ((ch ^ ((key >> 1) & 7)) << 4)) = ok ? kv[i] : z;
                *(LAS u32x4*)(lds + ATT_V_OFF + key * 128 + ((ch ^ (((key >> 1) & 1) << 2)) << 4)) = ok ? vv[i] : z;
            }
            if (kvh == 0) ATT_LOAD_K(1);
            __syncthreads();
            const float sk = sink[head] * LOG2E;
#pragma unroll
            for (int qt = 0; qt < 2; ++qt) {
                int lane_q = lane; asm volatile("" : "+v"(lane_q)); const int ql = lane_q & 31, hi = lane_q >> 5;
                const int q0 = 64 * qh + 32 * qt;
                const bf16_t* qrow = P + (tok0 + q0 + ql) * PW + C_Q + head * HD + 8 * hi;
                bf16x8 qf[4];
#pragma unroll
                for (int ks = 0; ks < 4; ++ks) qf[ks] = *(const bf16x8*)(qrow + 16 * ks);
                float m = sk, l = hi == 0 ? 1.f : 0.f;
                f32x16 negm;
#pragma unroll
                for (int r = 0; r < 16; ++r) negm[r] = -sk;
                f32x16 o[2];
#pragma unroll
                for (int r = 0; r < 16; ++r) { o[0][r] = 0.f; o[1][r] = 0.f; }
                const int kt0 = q0 >> 5;
                if (n - 1 + (kt0 >> 2) >= 0) attn_step<1>(lds, kt0, qf, koff, vb, ql, hi, m, l, o, negm);
#pragma unroll 1
                for (int j = 1; j < 8; ++j) { const int kt = kt0 + j; const int gb = n - 1 + (kt >> 2); if (gb >= 0 && gb < SEQ / 128) attn_step<0>(lds, kt, qf, koff, vb, ql, hi, m, l, o, negm); }
                if (n - 1 + ((kt0 + 8) >> 2) < SEQ / 128) attn_step<2>(lds, kt0 + 8, qf, koff, vb, ql, hi, m, l, o, negm);
                const float lt = xhalf_sum(l);
                const float inv = 1.0f / lt;
                float sq = 0.f;
#pragma unroll
                for (int dt = 0; dt < 2; ++dt)
#pragma unroll
                    for (int r = 0; r < 16; ++r) { o[dt][r] *= inv; sq += o[dt][r] * o[dt][r]; }
                sq = xhalf_sum(sq);
                if (hi == 0) ssq[head * 128 + q0 + ql] = sq;
                {   LAS unsigned char* stg = lds + ATT_STG_OFF + w * 4096;
#pragma unroll
                    for (int dt = 0; dt < 2; ++dt)
#pragma unroll
                        for (int g = 0; g < 4; ++g) {
                            const int c8 = 4 * dt + g;
                            u32x2 wv; wv.x = cvt_pk_bf16(o[dt][4 * g], o[dt][4 * g + 1]); wv.y = cvt_pk_bf16(o[dt][4 * g + 2], o[dt][4 * g + 3]);
                            *(LAS u32x2*)(stg + ql * 128 + ((c8 ^ (ql & 7)) << 4) + 8 * hi) = wv; }
                    asm volatile("s_waitcnt lgkmcnt(0)" ::: "memory");
#pragma unroll
                    for (int i = 0; i < 4; ++i) { const int row = 8 * i + (lane_q >> 3), ch = lane_q & 7;
                        const u32x4 v = *(const LAS u32x4*)(stg + row * 128 + ((ch ^ (row & 7)) << 4));
                        *(u32x4*)(Y + (tok0 + q0 + row) * D + head * HD + 8 * ch) = v; }
                    asm volatile("s_waitcnt lgkmcnt(0)" ::: "memory");
                }
            }
        }
        __syncthreads();
        if (tid < 128) { float s = 0.f;
#pragma unroll
            for (int h = 0; h < 8; ++h) s += ssq[h * 128 + tid];
            ((float*)(F.ws + WS_RSA))[tok0 + tid] = rsqrtf(s * (1.0f / AW) + EPS); }
        } else
        {
            int lane_c = lane; asm volatile("" : "+v"(lane_c));
            float cwv[3][8];
#pragma unroll
            for (int k = 0; k < 3; ++k) { const f32x4 a = *(const f32x4*)(cw + k * CW + 8 * lane_c), b2 = *(const f32x4*)(cw + k * CW + 8 * lane_c + 4);
#pragma unroll
                for (int jj = 0; jj < 4; ++jj) { cwv[k][jj] = a[jj]; cwv[k][4 + jj] = b2[jj]; } }
#pragma unroll 1
            for (int bt = 0; bt < 2; ++bt) {
                const int p0 = n * 128 + 16 * w + 8 * bt;
                const bf16_t* pr0 = P + (tok0 + 16 * w + 8 * bt) * PW;
                const u32x4 zero = (u32x4){0u, 0u, 0u, 0u};
                u32x4 cc[10], bb[8];
#pragma unroll
                for (int r = 0; r < 10; ++r) { const int pos = p0 - 1 + r; const bool ok = pos >= 0 && pos < SEQ;
                    cc[r] = ok ? *(const u32x4*)(pr0 + (ptrdiff_t)(r - 1) * PW + P_CU + 8 * lane_c) : zero; }
#pragma unroll
                for (int r = 0; r < 8; ++r) bb[r] = *(const u32x4*)(pr0 + (size_t)r * PW + C_B + 8 * lane_c);
                float cu[10][8];
#pragma unroll
                for (int r = 0; r < 10; ++r)
#pragma unroll
                    for (int wi = 0; wi < 4; ++wi) { cu[r][2 * wi] = bflo(cc[r][wi]); cu[r][2 * wi + 1] = bfhi(cc[r][wi]); }
#pragma unroll
                for (int r = 0; r < 8; ++r) {
                    float yc[8]; float s2 = 0.f;
#pragma unroll
                    for (int jj = 0; jj < 8; ++jj) {
                        const float gb = (jj & 1) ? bfhi(bb[r][jj >> 1]) : bflo(bb[r][jj >> 1]);
                        yc[jj] = gb * (cwv[0][jj] * cu[r][jj] + cwv[1][jj] * cu[r + 1][jj] + cwv[2][jj] * cu[r + 2][jj]); s2 += yc[jj] * yc[jj];
                    }
                    s2 = wave_sum(s2);
                    const float rstd = rsqrtf(s2 * (1.0f / CW) + EPS);
                    u32x4 wv; wv.x = cvt_pk_bf16(yc[0] * rstd, yc[1] * rstd); wv.y = cvt_pk_bf16(yc[2] * rstd, yc[3] * rstd); wv.z = cvt_pk_bf16(yc[4] * rstd, yc[5] * rstd); wv.w = cvt_pk_bf16(yc[6] * rstd, yc[7] * rstd);
                    *(u32x4*)(Y + (tok0 + 16 * w + 8 * bt + r) * D + AW + 8 * lane_c) = wv;
                }
            }
        }
        }
    }
}


constexpr int RT_PITCH = 2064;
constexpr int LCNT_WORD = 2304, GBASE_WORD = 2368;
__device__ __forceinline__ void router_stage(Frame& F, int l) {
    const bf16_t* WR = (const bf16_t*)(F.ws + WS_WR) + (size_t)l * 64 * D;
    const int tid = F.tid; LAS unsigned char* lds = F.lds;
    __syncthreads();
    u32x4 wv[9];
#pragma unroll
    for (int j = 0; j < 9; ++j) { const int i = tid + 512 * j; wv[j] = *(const u32x4*)(WR + (size_t)(i >> 7) * D + (i & 127) * 8); }
#pragma unroll
    for (int j = 0; j < 9; ++j) { const int i = tid + 512 * j; *(LAS u32x4*)(lds + (i >> 7) * RT_PITCH + (i & 127) * 16) = wv[j]; }
}
__device__ __forceinline__ void phase_router(Frame& F, int l, const float* brg, const float* bre) {
    const bf16_t* XB = (const bf16_t*)(F.ws + WS_XB);
    const float* SS = (const float*)(F.ws + WS_SS);
    float* RSTD = (float*)(F.ws + WS_RSTD); float* GATES = (float*)(F.ws + WS_GATES); int* LISTS = (int*)(F.ws + WS_LISTS);
    unsigned* cnt = F.ctl + CW_CNT + l * NE * 64;
    const int tid = F.tid, lane = F.lane, w = F.wave, ql = lane & 31, hi = lane >> 5;
    LAS unsigned char* lds = F.lds;
    volatile LAS unsigned* lcnt = F.MISC + LCNT_WORD; volatile LAS unsigned* gbase = F.MISC + GBASE_WORD;
    if (tid < NE) lcnt[tid] = 0u;
    __syncthreads();
    for (int unit = F.vcu; unit < T / 128; unit += F.G) {
        int e0 = 0, e1 = 0; unsigned rank0 = 0, rank1 = 0; float g0 = 0.f, g1 = 0.f, rstd = 0.f;
        const int t = unit * 128 + 32 * w + ql;
        if (w < 4) {
            f32x16 acc0, acc1;
#pragma unroll
            for (int r = 0; r < 16; ++r) { acc0[r] = 0.f; acc1[r] = 0.f; }
            const bf16_t* xr = XB + (size_t)t * D + 32 * hi;
            const LAS unsigned char* a0p = lds + ql * RT_PITCH + 64 * hi;
            const LAS unsigned char* a1p = lds + (32 + (ql < 3 ? ql : 3)) * RT_PITCH + 64 * hi;
#pragma unroll 4
            for (int a = 0; a < 16; ++a) {
                bf16x8 xv[4];
#pragma unroll
                for (int i = 0; i < 4; ++i) xv[i] = *(const bf16x8*)(xr + 64 * a + 8 * i);
#pragma unroll
                for (int i = 0; i < 4; ++i) {
                    const bf16x8 w0 = *(const LAS bf16x8*)(a0p + 128 * a + 16 * i), w1 = *(const LAS bf16x8*)(a1p + 128 * a + 16 * i);
                    acc0 = __builtin_amdgcn_mfma_f32_32x32x16_bf16(w0, xv[i], acc0, 0, 0, 0);
                    acc1 = __builtin_amdgcn_mfma_f32_32x32x16_bf16(w1, xv[i], acc1, 0, 0, 0);
                }
            }
            { float sv[8];
#pragma unroll
              for (int j = 0; j < 8; ++j) sv[j] = SS[(size_t)(8 * hi + j) * T + t];
              float ssum = (sv[0] + sv[1]) + (sv[2] + sv[3]) + (sv[4] + sv[5]) + (sv[6] + sv[7]); { auto rr = __builtin_amdgcn_permlane32_swap(__float_as_uint(ssum), __float_as_uint(ssum), false, false); ssum = __uint_as_float(rr[0]) + __uint_as_float(rr[1]); } rstd = rsqrtf(ssum * (1.0f / D) + EPS); }
            float gl[4];
#pragma unroll
            for (int g = 0; g < 4; ++g) { const float o = xhalf_other(acc1[g], hi != 0); gl[g] = (hi ? o : acc1[g]) * rstd + brg[g]; }
            int grp = 0; float gm = gl[0];
#pragma unroll
            for (int g = 1; g < 4; ++g) if (gl[g] > gm) { gm = gl[g]; grp = g; }
            float den = 0.f;
#pragma unroll
            for (int g = 0; g < 4; ++g) den += __expf(gl[g] - gm);
            const float pg = 1.0f / den;
            float own[4], oth[4], el[8];
#pragma unroll
            for (int i = 0; i < 4; ++i) { const float v = grp == 0 ? acc0[i] : grp == 1 ? acc0[4 + i] : grp == 2 ? acc0[8 + i] : acc0[12 + i]; own[i] = v * rstd + bre[8 * grp + 4 * hi + i]; }
#pragma unroll
            for (int i = 0; i < 4; ++i) oth[i] = xhalf_other(own[i], hi != 0);
#pragma unroll
            for (int i = 0; i < 4; ++i) { el[i] = hi ? oth[i] : own[i]; el[4 + i] = hi ? own[i] : oth[i]; }
            int i1 = 0; float l1 = el[0];
#pragma unroll
            for (int i = 1; i < 8; ++i) if (el[i] > l1) { l1 = el[i]; i1 = i; }
            int i2 = -1; float l2 = -3.0e38f;
#pragma unroll
            for (int i = 0; i < 8; ++i) if (i != i1 && el[i] > l2) { l2 = el[i]; i2 = i; }
            if (i2 < 0) i2 = (i1 + 1) & 7;
            const float ex = __expf(l2 - l1);
            e0 = grp * 8 + i1; e1 = grp * 8 + i2; g0 = pg / (1.0f + ex); g1 = pg * ex / (1.0f + ex);
            if (hi == 0) { rank0 = __hip_atomic_fetch_add((LAS unsigned*)(lcnt + e0), 1u, __ATOMIC_RELAXED, __HIP_MEMORY_SCOPE_WORKGROUP); rank1 = __hip_atomic_fetch_add((LAS unsigned*)(lcnt + e1), 1u, __ATOMIC_RELAXED, __HIP_MEMORY_SCOPE_WORKGROUP); }
        }
        __syncthreads();
        if (tid < NE) { const unsigned n = lcnt[tid]; gbase[tid] = n ? atomicAdd(cnt + tid * 64, n) : 0u; lcnt[tid] = 0u; }
        __syncthreads();
        if (w < 4 && hi == 0) {
            const unsigned rb = cvt_pk_bf16(0.f, rstd) & 0xffff0000u;
            LISTS[(size_t)e0 * LCAP + gbase[e0] + rank0] = (int)(rb | (unsigned)(t * 2)); LISTS[(size_t)e1 * LCAP + gbase[e1] + rank1] = (int)(rb | (unsigned)(t * 2 + 1));
            *(float2*)(GATES + t * 2) = make_float2(g0, g1);
        }
    }
}

__device__ __forceinline__ void phase_combine(Frame& F, const float* gfinal, float* out) {
    const int gw = F.vcu * NWAVES + F.wave, NGW = F.G * NWAVES;
    bf16_t* XB = (bf16_t*)(F.ws + WS_XB); const bf16_t* YK = (const bf16_t*)(F.ws + WS_YK); float* RSTD = (float*)(F.ws + WS_RSTD); const float* GATES = (const float*)(F.ws + WS_GATES);
    f32x4 gf[2][2];
#pragma unroll
    for (int j = 0; j < 2; ++j) { const int c0 = 8 * (F.lane + 64 * j); gf[j][0] = gfinal ? *(const f32x4*)(gfinal + c0) : (f32x4){0.f, 0.f, 0.f, 0.f}; gf[j][1] = gfinal ? *(const f32x4*)(gfinal + c0 + 4) : (f32x4){0.f, 0.f, 0.f, 0.f}; }
    for (int t = gw; t < T; t += NGW) {
        u32x4* xr = (u32x4*)(XB + (size_t)t * D) + F.lane;
        const u32x4* y0 = (const u32x4*)(YK + (size_t)(2 * t) * D) + F.lane; const u32x4* y1 = (const u32x4*)(YK + (size_t)(2 * t + 1) * D) + F.lane;
        float v[2][8]; float s = 0.f; const float ga = GATES[2 * t], gb = GATES[2 * t + 1];
#pragma unroll
        for (int j = 0; j < 2; ++j) { const u32x4 a = xr[64 * j], b = y0[64 * j], c = y1[64 * j];
#pragma unroll
            for (int i = 0; i < 4; ++i) { v[j][2 * i] = bflo(a[i]) + ga * bflo(b[i]) + gb * bflo(c[i]); v[j][2 * i + 1] = bfhi(a[i]) + ga * bfhi(b[i]) + gb * bfhi(c[i]); s += v[j][2 * i] * v[j][2 * i] + v[j][2 * i + 1] * v[j][2 * i + 1]; } }
        s = wave_sum(s);
        const float rstd = rsqrtf(s * (1.0f / D) + EPS);
        if (gfinal) {
#pragma unroll
            for (int j = 0; j < 2; ++j) { const int c0 = 8 * (F.lane + 64 * j); const f32x4 g0 = gf[j][0], g1 = gf[j][1];
                f32x4 o0, o1;
#pragma unroll
                for (int i = 0; i < 4; ++i) { o0[i] = v[j][i] * rstd * g0[i]; o1[i] = v[j][4 + i] * rstd * g1[i]; }
                *(f32x4*)(out + (size_t)t * D + c0) = o0; *(f32x4*)(out + (size_t)t * D + c0 + 4) = o1; }
        } else {
            if (F.lane == 0) RSTD[t] = rstd;
#pragma unroll
            for (int j = 0; j < 2; ++j) { u32x4 w; w.x = cvt_pk_bf16(v[j][0], v[j][1]); w.y = cvt_pk_bf16(v[j][2], v[j][3]); w.z = cvt_pk_bf16(v[j][4], v[j][5]); w.w = cvt_pk_bf16(v[j][6], v[j][7]); xr[64 * j] = w; }
        }
    }
}

__device__ __forceinline__ void moe_setup(Frame& F, int l) {
    __syncthreads();
    if (F.tid < 64) {
        const int e = F.tid & 31;
        const unsigned c = __hip_atomic_load(F.ctl + CW_CNT + (l * NE + e) * 64, __ATOMIC_RELAXED, __HIP_MEMORY_SCOPE_AGENT);
        const unsigned tl = (c + 255u) / 256u;
        unsigned inc = tl;
#pragma unroll
        for (int o = 1; o < 32; o <<= 1) { const unsigned v = (unsigned)__builtin_amdgcn_ds_bpermute(((F.tid - o) & 63) << 2, (int)inc); if (e >= o) inc += v; }
        if (F.tid < 32) { F.MISC[64 + e] = c; F.MISC[16 + e] = inc - tl; if (e == 31) F.MISC[16 + NE] = inc; }
    }
    __syncthreads();
}

constexpr int N_PHASES = 1 + 7 * DEPTH;
__global__ void __launch_bounds__(NWAVES * 64, 2) mk_fwd(Args args) {
    extern __shared__ __attribute__((aligned(16))) unsigned char lds[];
    Frame F;
    F.lds = (LAS unsigned char*)lds; F.MISC = (volatile LAS unsigned*)(F.lds + MISC_OFF);
    F.wave = __builtin_amdgcn_readfirstlane((int)threadIdx.x >> 6); F.lane = lane_id(); F.tid = F.wave * 64 + F.lane;
    F.G = gridDim.x; { const int bx = blockIdx.x; F.vcu = (F.G % 8 == 0) ? (bx % 8) * (F.G / 8) + bx / 8 : bx; }
    F.ws = args.ws; F.ctl = (unsigned*)(args.ws + WS_CTL);
    for (int u = F.tid; u < 512; u += NWAVES * 64) F.MISC[u] = 0u;
    __syncthreads();
    if (F.tid == 0) {
        volatile LAS unsigned long long* pt = (volatile LAS unsigned long long*)(F.MISC + 128);
#define PT_(i) pt[i] = (unsigned long long)(uintptr_t)args.in[i];
        PT_(0) PT_(1) PT_(2) PT_(3) PT_(4) PT_(5) PT_(6) PT_(7) PT_(8) PT_(9) PT_(10) PT_(11) PT_(12) PT_(13) PT_(14) PT_(15) PT_(16)
#undef PT_
        pt[17] = (unsigned long long)(uintptr_t)args.out;
    }
    __syncthreads();
#if MK_ONE_LAUNCH
    XcdBarrier bar = xcd_barrier_post(F.ctl + CW_BAR, F.MISC + 0, F.tid);
#define GRID_BAR() xcd_barrier(bar, F.wave)
#else
#define GRID_BAR() do {} while (0)
#endif
    const int lo = args.ph_lo, hi = args.ph_hi;
#define IN(k) (lo <= (k) && (k) < hi)
#define SEAM(k) do { if (IN(k) && IN((k) + 1)) GRID_BAR(); } while (0)
    if (IN(0)) { relaunder(F); phase_prologue(F); SEAM(0); }
    for (int l = 0; l < DEPTH; ++l) {
        const int p = 1 + 7 * l;
        if (IN(p)) { relaunder(F);
            { const int ng = gemm_cus((T / 256) * 9, F.G); unsigned* ctr = F.ctl + CW_CONV + (l * 3 + 0) * 64;
              DenseSched<13> S{F.ws, l, ng, F.bx}; EpiG1 E{F.ws};
              const unsigned pk = pg8::gemm_phase<EpiG1, DenseSched<13>, false, true>(F.lds, F.MISC + 256, D, S, E, F.wave, ctr);
              relaunder(F);
              convert_work(F, ctr, cv_start(l, 0), cv_end(l, 0), F.bx >= ng, pk); }
            SEAM(p);
        }
        if (IN(p + 1)) { relaunder(F); phase_mixer(F, in_ptr(F, 3) + l * NH, in_ptr(F, 4) + (size_t)l * 3 * CW); SEAM(p + 1); }
        if (IN(p + 2)) { relaunder(F);
            DenseSched<2> S{F.ws, l, F.G, F.bx};
            EpiResid E{F.ws};
            pg8::gemm_phase<EpiResid, DenseSched<2>, false, true>(F.lds, F.MISC + 256, D, S, E, F.wave);
            relaunder(F); router_stage(F, l);
            SEAM(p + 2);
        }
        if (IN(p + 3)) { relaunder(F); if (!IN(p + 2)) router_stage(F, l); phase_router(F, l, in_ptr(F, 10) + l * NG, in_ptr(F, 12) + l * NE); SEAM(p + 3); }
        if (IN(p + 4)) { relaunder(F);
            moe_setup(F, l);
            const int ng = gemm_cus((int)F.MISC[16 + NE] * 4, F.G); unsigned* ctr = F.ctl + CW_CONV + (l * 3 + 1) * 64;
            MoeSched<true> S{F.ws, l, F.MISC, ng, F.bx};
            EpiAct E{S};
            const unsigned pk = pg8::gemm_phase<EpiAct, MoeSched<true>, true, true>(F.lds, F.MISC + 256, D, S, E, F.wave, ctr);
            relaunder(F);
            convert_work(F, ctr, cv_start(l, 1), cv_end(l, 1), F.bx >= ng, pk);
            SEAM(p + 4);
        }
        if (IN(p + 5)) { relaunder(F);
            const int ng = gemm_cus((int)F.MISC[16 + NE] * 4, F.G); unsigned* ctr = F.ctl + CW_CONV + (l * 3 + 2) * 64;
            MoeSched<false> S{F.ws, l, F.MISC, ng, F.bx};
            EpiDown E{S};
            const unsigned pk = pg8::gemm_phase<EpiDown, MoeSched<false>, false, true>(F.lds, F.MISC + 256, DE, S, E, F.wave, ctr);
            relaunder(F);
            convert_work(F, ctr, cv_start(l, 2), cv_end(l, 2), F.bx >= ng, pk);
            SEAM(p + 5);
        }
        if (IN(p + 6)) { relaunder(F); phase_combine(F, l == DEPTH - 1 ? in_ptr(F, 16) : nullptr, (float*)in_ptr(F, 17)); if (l < DEPTH - 1) SEAM(p + 6); }
    }
}

extern "C" void kernel_launch(void* const* d_in, const int* in_sizes, int n_in, void* d_out, int out_size, void* d_ws, size_t ws_size, hipStream_t stream) {
    static int grid = 0;
    if (grid == 0) {
        if (n_in != 17 || ws_size < WS_END) { fprintf(stderr, "kernel_launch: bad inputs (n_in %d, ws %zu)\n", n_in, ws_size); grid = -1; return; }
        int dev = 0, cus = 0, per_cu = 0;
        if (hipGetDevice(&dev) != hipSuccess || hipDeviceGetAttribute(&cus, hipDeviceAttributeMultiprocessorCount, dev) != hipSuccess) { grid = -1; return; }
        if (hipFuncSetAttribute((const void*)mk_fwd, hipFuncAttributeMaxDynamicSharedMemorySize, LDS_BYTES) != hipSuccess) { fprintf(stderr, "kernel_launch: hipFuncSetAttribute failed\n"); grid = -1; return; }
        if (hipOccupancyMaxActiveBlocksPerMultiprocessor(&per_cu, (const void*)mk_fwd, NWAVES * 64, LDS_BYTES) != hipSuccess || per_cu < 1) { fprintf(stderr, "kernel_launch: occupancy query says %d\n", per_cu); per_cu = 1; }
        (void)hipGetLastError();
        grid = cus;
    }
    if (grid < 0) return;
    (void)hipMemsetAsync((char*)d_ws + WS_CTL, 0, CTL_ZERO_BYTES, stream);
    Args a; memset(&a, 0, sizeof(a));
    for (int i = 0; i < 17; ++i) a.in[i] = (const float*)d_in[i];
    a.out = (float*)d_out; a.ws = (unsigned char*)d_ws;
#if MK_ONE_LAUNCH
    a.ph_lo = 0; a.ph_hi = N_PHASES;
    hipLaunchKernelGGL(mk_fwd, dim3(grid), dim3(NWAVES * 64), LDS_BYTES, stream, a);
#else
    for (int p = 0; p < N_PHASES; ++p) { a.ph_lo = p; a.ph_hi = p + 1; hipLaunchKernelGGL(mk_fwd, dim3(grid), dim3(NWAVES * 64), LDS_BYTES, stream, a); }
#endif
}
```

```cpp
#include <hip/hip_runtime.h>
#include <cstdio>
#include <cstdint>
#include <cstring>

#ifndef MK_ONE_LAUNCH
#define MK_ONE_LAUNCH 1
#endif

constexpr int D = 1024, BATCH = 4, SEQ = 8192, T = BATCH * SEQ, DEPTH = 4;
constexpr int NH = 8, HD = 64, AW = 512, CW = 512, INW = 2304;
constexpr int C_Q = 0, C_K = 512, C_V = 640, C_B = 768, C_C = 1280, C_U = 1792;
constexpr int PW = 1792, P_CU = 1280;
constexpr int NE = 32, NG = 4, DE = 512;
constexpr int WIN = 128;
constexpr float EPS = 1e-6f;
constexpr float QSCALE = 0.125f * 1.4426950408889634f;
constexpr float LOG2E = 1.4426950408889634f;
constexpr int LCAP = T;
constexpr int MAXSLOTS = 2 * T + NE * 256;

#define LAS __attribute__((address_space(3)))
#define GAS __attribute__((address_space(1)))
typedef unsigned short bf16_t;
typedef short bf16x8 __attribute__((ext_vector_type(8)));
typedef float f32x4 __attribute__((ext_vector_type(4)));
typedef unsigned u32x4 __attribute__((ext_vector_type(4)));
typedef unsigned u32x2 __attribute__((ext_vector_type(2)));

constexpr size_t MiB = 1u << 20;
constexpr size_t WS_CTL = 0, CTL_ZERO_BYTES = 192 * 1024;
constexpr size_t WS_CS = 1 * MiB;
constexpr size_t WS_RSTD = 2 * MiB;
constexpr size_t WS_SS = 3 * MiB;
constexpr size_t WS_GATES = 5 * MiB;
constexpr size_t WS_RSA = 5 * MiB + 512 * 1024;
constexpr size_t WS_LISTS = 6 * MiB;
constexpr size_t WS_WR = 10 * MiB;
constexpr size_t WS_WIN = 12 * MiB;
constexpr size_t WS_WOUT = 30 * MiB;
constexpr size_t WS_WGU = 40 * MiB;
constexpr size_t WS_WDN = 296 * MiB;
constexpr size_t WS_XB = 424 * MiB;
constexpr size_t WS_PROJ = 488 * MiB;
constexpr size_t WS_Y = 632 * MiB;
constexpr size_t WS_ACT = 696 * MiB;
constexpr size_t WS_YK = 768 * MiB;
constexpr size_t WS_DUMMY = 896 * MiB;
constexpr size_t WS_END = 897 * MiB;
constexpr int CW_BAR = 4096;
constexpr int CW_CONV = 8192;
constexpr int CW_XL = 24576;
constexpr int CW_CNT = 16384;

constexpr int RING_BYTES = 131072;
constexpr int MISC_OFF = RING_BYTES;
constexpr int LDS_BYTES = 147456;

__device__ __forceinline__ float bf2f(unsigned short b) { return __uint_as_float((unsigned)b << 16); }
__device__ __forceinline__ float bflo(unsigned w) { return __uint_as_float(w << 16); }
__device__ __forceinline__ float bfhi(unsigned w) { return __uint_as_float(w & 0xffff0000u); }
typedef float f32x2_t __attribute__((ext_vector_type(2)));
typedef __bf16 bf16x2_t __attribute__((ext_vector_type(2)));
__device__ __forceinline__ unsigned cvt_pk_bf16(float lo, float hi) { const f32x2_t v = {lo, hi}; const bf16x2_t b = __builtin_convertvector(v, bf16x2_t); return __builtin_bit_cast(unsigned, b); }
__device__ __forceinline__ float wave_sum(float v) {
#define WS_DPP(x, ctrl) __uint_as_float((unsigned)__builtin_amdgcn_update_dpp(0, (int)__float_as_uint(x), ctrl, 0xf, 0xf, false))
    v += WS_DPP(v, 0xB1); v += WS_DPP(v, 0x4E); v += WS_DPP(v, 0x124); v += WS_DPP(v, 0x128);
#undef WS_DPP
    { auto rr = __builtin_amdgcn_permlane16_swap(__float_as_uint(v), __float_as_uint(v), false, false); v = __uint_as_float(rr[0]) + __uint_as_float(rr[1]); }
    { auto rr = __builtin_amdgcn_permlane32_swap(__float_as_uint(v), __float_as_uint(v), false, false); v = __uint_as_float(rr[0]) + __uint_as_float(rr[1]); }
    return v;
}
__device__ __forceinline__ float xrow_sum(float v) { auto rr = __builtin_amdgcn_permlane16_swap(__float_as_uint(v), __float_as_uint(v), false, false); return __uint_as_float(rr[0]) + __uint_as_float(rr[1]); }
__device__ __forceinline__ float xhalf_other(float v, bool upper) { auto rr = __builtin_amdgcn_permlane32_swap(__float_as_uint(v), __float_as_uint(v), false, false); return __uint_as_float(upper ? rr[0] : rr[1]); }
__device__ __forceinline__ int lane_id() { int r; asm volatile("v_mbcnt_lo_u32_b32 %0, -1, 0\n\tv_mbcnt_hi_u32_b32 %0, -1, %0" : "=&v"(r)); return r; }
#define LDS_WAIT() asm volatile("s_waitcnt lgkmcnt(0)" ::: "memory")
#define VM_WAIT() asm volatile("s_waitcnt vmcnt(0)" ::: "memory")

namespace pg8 {
constexpr int BM = 256, BK = 64, HALF = 128, HTB = HALF * BK * 2, STAGE_BYTES = 8 * HTB, NXCD = 8, WGM = 8;
__host__ __device__ __forceinline__ int lds_byte(int r, int c) { const int st = (r >> 4) * 2 + (c >> 5), rr = r & 15, cc = c & 31, ob = rr * 64 + cc * 2; return st * 1024 + (ob ^ (((ob >> 9) & 1) << 5)); }
__host__ __device__ __forceinline__ void stage_rc(int b, int& R, int& C) { const int st = b / 1024, sb = b % 1024, swz = sb ^ (((sb >> 9) & 1) << 5); R = (st >> 1) * 16 + swz / 64; C = (st & 1) * 32 + (swz % 64) / 2; }
__host__ __device__ __forceinline__ int perm32(int rho) { const int n = rho >> 4, i = rho & 15; return 8 * (i >> 2) + 4 * n + (i & 3); }

struct Unit { int pm, pn, e, lt, nvalid; };

__device__ __forceinline__ bool tile_order(int L, int nM, int nN, int& pm, int& pn) {
    const int nwg = nM * nN; if (L >= nwg) return false;
    int wgid = L; { const int q = nwg / NXCD, r = nwg % NXCD, xcd = wgid % NXCD, off = wgid / NXCD; wgid = (xcd < r ? xcd * (q + 1) : r * (q + 1) + (xcd - r) * q) + off; }
    const int nig = WGM * nN, gid = wgid / nig, fm = gid * WGM, gsz = (nM - fm) < WGM ? (nM - fm) : WGM;
    pm = fm + ((wgid % nig) % gsz); pn = (wgid % nig) / gsz; return true;
}

template <class Epi, class Sched, bool GATHER, bool TABLE>
__device__ __forceinline__ unsigned gemm_phase(LAS unsigned char* lds, volatile LAS unsigned* tab, const int K, const Sched& S, const Epi& E, const int wave, unsigned* peek = nullptr) {
    int tid = wave * 64 + lane_id(); asm volatile("" : "+v"(tid));
    const int wid = wave, lane = tid & 63, wr = wid >> 2, wc = wid & 3, fr = lane & 15, fq = lane >> 4;
    const int nt = K / BK;
    constexpr int NST = Epi::NSTORE;
    unsigned voffB[2][2], cvo[2][2];
    {   int RR[2], CC[2];
#pragma unroll
        for (int i = 0; i < 2; ++i) { stage_rc(tid * 16 + i * 8192, RR[i], CC[i]); const int Rb = (RR[i] & ~31) + perm32(RR[i] & 31);
            voffB[0][i] = (unsigned)((64 * (RR[i] >> 5) + perm32(RR[i] & 31)) * K + CC[i]) * 2u; voffB[1][i] = voffB[0][i] + (unsigned)(32 * K * 2); (void)Rb;
            cvo[0][i] = (unsigned)(RR[i] * K + CC[i]) * 2u; cvo[1][i] = (unsigned)((RR[i] + HALF) * K + CC[i]) * 2u; } }
#define PG8_GATHER_VO(dst, tbl) do { int tid2_ = tid; asm volatile("" : "+v"(tid2_)); _Pragma("unroll") for (int i_ = 0; i_ < 2; ++i_) { int R_, C_; stage_rc(tid2_ * 16 + i_ * 8192, R_, C_); \
        _Pragma("unroll") for (int h_ = 0; h_ < 2; ++h_) dst[h_][i_] = (((tbl)[h_ * HALF + R_] & 0xfffeu) << 10) + (unsigned)C_ * 2u; } } while (0)
    const size_t kstep = (size_t)(BK * 2);
    const size_t hstep = (size_t)HALF * K * 2;
    const unsigned ldsw = (unsigned)wid * 1024u;
    const unsigned ldsbase = (unsigned)__builtin_amdgcn_readfirstlane((int)((unsigned)(uintptr_t)lds + ldsw));
    const int aoff = lds_byte(wr * 64 + fr, fq * 8), boff = lds_byte(wc * 32 + fr, fq * 8);
#define PG8_SA(b, h) (((b) * 2 + (h)) * HTB)
#define PG8_SB(b, h) ((4 + (b) * 2 + (h)) * HTB)
#define PG8_GLDS(gbase, voff32, ldsdst) do { unsigned keep_; asm volatile("s_mov_b32 %0, m0\n\ts_mov_b32 m0, %3\n\ts_nop 4\n\tglobal_load_lds_dwordx4 %1, %2\n\ts_mov_b32 m0, %0" \
        : "=&s"(keep_) : "v"(voff32), "s"(gbase), "s"(ldsdst) : "memory"); } while (0)
#define PG8_STAGE(bufoff, gbase, voff) do { _Pragma("unroll") for (int _i = 0; _i < 2; ++_i) \
        PG8_GLDS((const char*)(gbase), (voff)[_i], ldsbase + (unsigned)((bufoff) + _i * 8192)); } while (0)
#define PG8_LDA(dst, b, h) do { _Pragma("unroll") for (int m = 0; m < 4; ++m) _Pragma("unroll") for (int k = 0; k < 2; ++k) dst[m][k] = *(const LAS bf16x8*)(lds + PG8_SA(b, h) + aoff + m * 2048 + k * 1024); } while (0)
#define PG8_LDB(dst, b, h) do { _Pragma("unroll") for (int n = 0; n < 2; ++n) _Pragma("unroll") for (int k = 0; k < 2; ++k) dst[n][k] = *(const LAS bf16x8*)(lds + PG8_SB(b, h) + boff + n * 2048 + k * 1024); } while (0)
#define PG8_MMA(ai, bj, At, Bt) do { __builtin_amdgcn_s_setprio(1); _Pragma("unroll") for (int m = 0; m < 4; ++m) _Pragma("unroll") for (int n = 0; n < 2; ++n) _Pragma("unroll") for (int k = 0; k < 2; ++k) \
        acc[ai][bj][m][n] = __builtin_amdgcn_mfma_f32_16x16x32_bf16(Bt[n][k], At[m][k], acc[ai][bj][m][n], 0, 0, 0); __builtin_amdgcn_s_setprio(0); } while (0)
#define PG8_WAIT_V(n) asm volatile("s_waitcnt vmcnt(" #n ")" ::: "memory")
#define PG8_WAIT_VF(n) do { if (fresh) asm volatile("s_waitcnt vmcnt(%0)" :: "n"((n) + NST) : "memory"); else asm volatile("s_waitcnt vmcnt(8)" ::: "memory"); } while (0)
#define PG8_WAIT_L(n) asm volatile("s_waitcnt lgkmcnt(" #n ")" ::: "memory")
#define PG8_BAR __builtin_amdgcn_s_barrier()
#define PG8_SCHED __builtin_amdgcn_sched_barrier(0)
    Unit cur, nxt; int ui = 0;
    unsigned pk = 0u;
    if (!S.next(0, cur)) return 0u;
    f32x4 acc[2][2][4][2];
#pragma unroll
    for (int a = 0; a < 2; ++a)
#pragma unroll
        for (int b = 0; b < 2; ++b)
#pragma unroll
            for (int m = 0; m < 4; ++m)
#pragma unroll
                for (int n = 0; n < 2; ++n) acc[a][b][m][n] = (f32x4){0.f, 0.f, 0.f, 0.f};
    bf16x8 At[4][2], B0[2][2], B1[2][2];
    const char* cA = S.a_ptr(cur); const char* cB = S.b_ptr(cur);
    bool has_next = S.next(1, nxt);
    unsigned rinfo = 0u, rinfo0 = 0u;
    PG8_STAGE(PG8_SB(0, 0), cB, voffB[0]); PG8_STAGE(PG8_SB(0, 1), cB, voffB[1]);
    if constexpr (TABLE) {
        if (tid < 256) { rinfo0 = S.row_info(cur, tid); if (has_next) rinfo = S.row_info(nxt, tid); }
        if constexpr (GATHER) {
            if (tid < 256) tab[tid] = rinfo0;
            asm volatile("s_waitcnt vmcnt(0) lgkmcnt(0)" ::: "memory"); __builtin_amdgcn_s_barrier(); asm volatile("" ::: "memory");
            PG8_GATHER_VO(cvo, tab);
        }
    }
    int tb = 0;
    PG8_STAGE(PG8_SA(0, 0), cA, cvo[0]); PG8_STAGE(PG8_SA(0, 1), cA, cvo[1]);
    if (wr == 1) PG8_BAR;
    PG8_WAIT_V(2); PG8_BAR;
    if constexpr (TABLE && !GATHER) { if (tid < 256) tab[tid] = rinfo0; }
    PG8_STAGE(PG8_SB(1, 0), cB + kstep, voffB[0]); PG8_STAGE(PG8_SA(1, 0), cA + kstep, cvo[0]); PG8_STAGE(PG8_SB(1, 1), cB + kstep, voffB[1]);
    PG8_WAIT_V(6); PG8_BAR;
    for (;;) {
        const char* nA = has_next ? S.a_ptr(nxt) : cA; const char* nB = has_next ? S.b_ptr(nxt) : cB;
        Unit nn; const bool has_nn = has_next && S.next(ui + 2, nn);
        if (peek != nullptr && !has_next && tid == 0) pk = __hip_atomic_load(peek, __ATOMIC_RELAXED, __HIP_MEMORY_SCOPE_AGENT);
        if constexpr (TABLE) {
            { int t2 = tid; asm volatile("" : "+v"(t2));
              if (has_next) { if (t2 < 256) tab[(tb == 2 ? 0 : tb + 1) * 256 + t2] = rinfo; }
              if (has_nn) { if (t2 < 256) rinfo = S.row_info(nn, t2); } }
        }
        for (int t = 0; t < nt; t += 2) {
            const bool last = (t == nt - 2);
            const bool fresh = (t == 0) && (ui > 0);
            const char* a1 = cA + (size_t)(t + 1) * kstep;
            const char* a2 = last ? nA : cA + (size_t)(t + 2) * kstep; const char* b2 = last ? nB : cB + (size_t)(t + 2) * kstep;
            const char* a3 = a2 + kstep; const char* b3 = b2 + kstep;
            unsigned vo2[2][2];
#pragma unroll
            for (int h = 0; h < 2; ++h)
#pragma unroll
                for (int i = 0; i < 2; ++i) vo2[h][i] = cvo[h][i];
            if constexpr (GATHER) { if (last && has_next) PG8_GATHER_VO(vo2, tab + (tb == 2 ? 0 : tb + 1) * 256); }
            PG8_LDB(B0, 0, 0); PG8_LDB(B1, 0, 1); PG8_SCHED; PG8_LDA(At, 0, 0); if (!fresh) PG8_STAGE(PG8_SA(1, 1), a1, cvo[1]);
            PG8_WAIT_VF(8); PG8_WAIT_L(0); PG8_BAR; PG8_MMA(0, 0, At, B0); PG8_MMA(0, 1, At, B1); PG8_BAR; PG8_SCHED;
            PG8_LDA(At, 0, 1); PG8_STAGE(PG8_SB(0, 0), b2, voffB[0]); PG8_STAGE(PG8_SB(0, 1), b2, voffB[1]); PG8_STAGE(PG8_SA(0, 0), a2, vo2[0]);
            PG8_WAIT_VF(14); PG8_WAIT_L(0); PG8_BAR; PG8_MMA(1, 0, At, B0); PG8_MMA(1, 1, At, B1); PG8_BAR; PG8_SCHED;
            PG8_LDB(B0, 1, 0); PG8_LDB(B1, 1, 1); PG8_SCHED; PG8_LDA(At, 1, 0); PG8_STAGE(PG8_SA(0, 1), a2, vo2[1]);
            PG8_WAIT_VF(10); PG8_WAIT_L(0); PG8_BAR; PG8_MMA(0, 0, At, B0); PG8_MMA(0, 1, At, B1); PG8_BAR; PG8_SCHED;
            PG8_LDA(At, 1, 1); PG8_STAGE(PG8_SB(1, 0), b3, voffB[0]); PG8_STAGE(PG8_SB(1, 1), b3, voffB[1]); PG8_STAGE(PG8_SA(1, 0), a3, vo2[0]);
            PG8_WAIT_VF(14); PG8_WAIT_L(0); PG8_BAR; PG8_MMA(1, 0, At, B0); PG8_MMA(1, 1, At, B1); PG8_BAR; PG8_SCHED;
            if (last) PG8_STAGE(PG8_SA(1, 1), a3, vo2[1]);
            if constexpr (Epi::MIDSCALE) {
                if ((t + 2) * BK == Epi::MIDK) {
#pragma unroll
                    for (int a = 0; a < 2; ++a)
#pragma unroll
                        for (int m = 0; m < 4; ++m) { const float rsc = __uint_as_float(tab[tb * 256 + a * 128 + wr * 64 + m * 16 + fr]);
#pragma unroll
                            for (int b = 0; b < 2; ++b)
#pragma unroll
                                for (int n = 0; n < 2; ++n) acc[a][b][m][n] *= rsc; }
                }
            }
        }
        if (wr == 0) PG8_BAR;
        { int fr_ = fr, fq_ = fq; asm volatile("" : "+v"(fr_), "+v"(fq_)); E(acc, cur, wr, wc, fr_, fq_, tab + tb * 256); }
        if (!has_next) break;
#pragma unroll
        for (int a = 0; a < 2; ++a)
#pragma unroll
            for (int b = 0; b < 2; ++b)
#pragma unroll
                for (int m = 0; m < 4; ++m)
#pragma unroll
                    for (int n = 0; n < 2; ++n) acc[a][b][m][n] = (f32x4){0.f, 0.f, 0.f, 0.f};
        cur = nxt; cA = nA; cB = nB; ++ui; tb = (tb == 2 ? 0 : tb + 1); nxt = nn; has_next = has_nn;
        if constexpr (GATHER) PG8_GATHER_VO(cvo, tab + tb * 256);
        if (wr == 1) PG8_BAR;
    }
    PG8_WAIT_V(0);
    PG8_BAR;
    return pk;
#undef PG8_GATHER_VO
#undef PG8_SA
#undef PG8_SB
#undef PG8_STAGE
#undef PG8_GLDS
#undef PG8_LDA
#undef PG8_LDB
#undef PG8_MMA
#undef PG8_WAIT_V
#undef PG8_WAIT_VF
#undef PG8_WAIT_L
#undef PG8_BAR
#undef PG8_SCHED
}
}

#define XB_TMO      128
#define XB_XCNT(j)  (256  + 64 * (j))
#define XB_XSUB(j)  (1280 + 64 * (j))
#define XB_XGEN(j)  (2304 + 64 * (j))
#define XB_TOP      3328
#define XB_TOPGEN   3392
#define XCD_BAR_WORDS 3456
#define XB_SPIN_CAP (1u << 18)
__device__ __forceinline__ unsigned xb_ld(unsigned* p)              { return __hip_atomic_load(p, __ATOMIC_RELAXED, __HIP_MEMORY_SCOPE_AGENT); }
__device__ __forceinline__ unsigned xb_add(unsigned* p, unsigned v) { return __hip_atomic_fetch_add(p, v, __ATOMIC_RELAXED, __HIP_MEMORY_SCOPE_AGENT); }
__device__ __forceinline__ unsigned xb_xcc_id() { return (unsigned)__builtin_amdgcn_s_getreg((3 << 11) | 20) & 0xFu; }
#define XB_SPIN(cond, bar) do { unsigned _sp = 0; while (cond) { __builtin_amdgcn_s_sleep(1); \
    if ((++_sp & 255u) == 0u) { if (xb_ld(&(bar)[XB_TMO])) break; if (_sp > XB_SPIN_CAP) { atomicAdd(&(bar)[XB_TMO], 1u); break; } } } } while (0)
struct XcdBarrier { unsigned* bar; unsigned x; volatile LAS unsigned* st; };
__device__ __forceinline__ XcdBarrier xcd_barrier_post(unsigned* bar, volatile LAS unsigned* st, int tid) {
    XcdBarrier b; b.bar = bar; b.x = xb_xcc_id(); b.st = st;
    if (tid == 0) st[2] = xb_add(&bar[XB_XCNT(b.x)], 1u);
    return b;
}
__device__ __forceinline__ void xcd_barrier_complete(unsigned* bar, unsigned x, unsigned& nloc, unsigned& nx, unsigned& xord, unsigned& uni) {
    const unsigned G = gridDim.x * gridDim.y * gridDim.z;
    unsigned sum, cnt, mine, below, odd, sp = 0u;
    for (;;) {
        sum = 0u; cnt = 0u; mine = 0u; below = 0u; odd = 0u;
#pragma unroll
        for (unsigned j = 0; j < 16; ++j) { const unsigned c = xb_ld(&bar[XB_XCNT(j)]); sum += c; cnt += (c > 0u) ? 1u : 0u; mine = (j == x) ? c : mine; below += (j < x && c > 0u) ? 1u : 0u; odd += (c != 0u && c != 32u) ? 1u : 0u; }
        if (sum == G) break;
        __builtin_amdgcn_s_sleep(1);
        if ((++sp & 255u) == 0u) { if (xb_ld(&bar[XB_TMO])) break; if (sp > XB_SPIN_CAP) { atomicAdd(&bar[XB_TMO], 1u); break; } }
    }
    nloc = mine > 0u ? mine : 1u; nx = cnt > 0u ? cnt : 1u;
    xord = below; uni = (sum == G && G == 256u && cnt == 8u && odd == 0u) ? 1u : 0u;
}
__device__ __forceinline__ void xcd_barrier(const XcdBarrier& b, int wave) {
    asm volatile("s_waitcnt vmcnt(0)" ::: "memory");
    __syncthreads();
    if (wave == 0 && lane_id() == 0) {
        unsigned* bar = b.bar;
        __builtin_amdgcn_s_waitcnt(0);
        unsigned nloc = b.st[0], nx = b.st[1];
        if (nloc == 0u) { unsigned xord, uni; xcd_barrier_complete(bar, b.x, nloc, nx, xord, uni); b.st[0] = nloc; b.st[1] = nx; b.st[3] = xord; b.st[4] = uni; }
        const unsigned old = xb_add(&bar[XB_XSUB(b.x)], 1u);
        const unsigned gen = old / nloc;
        if (old + 1u == (gen + 1u) * nloc) {
            __builtin_amdgcn_fence(__ATOMIC_RELEASE, "agent");
            asm volatile("s_waitcnt vmcnt(0)" ::: "memory");
            (void)xb_add(&bar[XB_TOP], 1u);
        }
        XB_SPIN(xb_ld(&bar[XB_TOP]) < (gen + 1u) * nx, bar);
        __builtin_amdgcn_fence(__ATOMIC_ACQUIRE, "agent");
        asm volatile("s_waitcnt vmcnt(0)" ::: "memory");
    }
    __syncthreads();
}

__device__ __forceinline__ void xcc_local_barrier(unsigned* w, unsigned* bar, int wave) {
    asm volatile("s_waitcnt vmcnt(0)" ::: "memory");
    __syncthreads();
    if (wave == 0 && lane_id() == 0) {
        (void)xb_add(w, 1u);
        XB_SPIN(xb_ld(w) < 32u, bar);
        __builtin_amdgcn_fence(__ATOMIC_ACQUIRE, "agent");
        asm volatile("s_waitcnt vmcnt(0)" ::: "memory");
    }
    __syncthreads();
}

__device__ __forceinline__ void xcc_pair_barrier(unsigned* wx, unsigned* wp, unsigned* bar, int wave) {
    asm volatile("s_waitcnt vmcnt(0)" ::: "memory");
    __syncthreads();
    if (wave == 0 && lane_id() == 0) {
        const unsigned old = xb_add(wx, 1u);
        if (old + 1u == 32u) {
            __builtin_amdgcn_fence(__ATOMIC_RELEASE, "agent");
            asm volatile("s_waitcnt vmcnt(0)" ::: "memory");
            (void)xb_add(wp, 1u);
        }
        XB_SPIN(xb_ld(wp) < 2u, bar);
        __builtin_amdgcn_fence(__ATOMIC_ACQUIRE, "agent");
        asm volatile("s_waitcnt vmcnt(0)" ::: "memory");
    }
    __syncthreads();
}

struct Args {
    const float* in[17]; float* out; unsigned char* ws; int ph_lo, ph_hi;
};
struct Frame {
    LAS unsigned char* lds; volatile LAS unsigned* MISC; unsigned* ctl;
    int tid, lane, wave, vcu, G, bx, cx, uni, xcc, xord;
    unsigned char* ws;
};
constexpr int NWAVES = 8;
__device__ __forceinline__ void relaunder(Frame& F) {
    unsigned m = (unsigned)(uintptr_t)F.MISC, d = (unsigned)(uintptr_t)F.lds; asm volatile("" : "+s"(m), "+s"(d));
    F.MISC = (volatile LAS unsigned*)(uintptr_t)m; F.lds = (LAS unsigned char*)(uintptr_t)d;
    asm volatile("" : "+s"(F.wave), "+s"(F.vcu));
    F.bx = F.cx; asm volatile("" : "+s"(F.bx));
    F.lane = lane_id(); F.tid = F.wave * 64 + F.lane;
    asm volatile("" : "+v"(F.tid), "+v"(F.lane));
    unsigned long long w = (unsigned long long)(uintptr_t)F.ws; asm volatile("" : "+s"(w)); F.ws = (unsigned char*)(GAS unsigned char*)(uintptr_t)w;
}
__device__ __forceinline__ const float* in_ptr(const Frame& F, int i) {
    volatile LAS unsigned* p = F.MISC + 128 + 2 * i;
    const unsigned lo = __builtin_amdgcn_readfirstlane(p[0]), hi = __builtin_amdgcn_readfirstlane(p[1]);
    return (const float*)(const GAS float*)(uintptr_t)(((unsigned long long)hi << 32) | lo);
}

template <int WHICH>
struct DenseSched {
    unsigned char* ws; int l, G, c;
    static constexpr int nM = T / 256, nN = WHICH == 1 ? 5 : WHICH == 13 ? 9 : 4, pn0 = WHICH == 3 ? 5 : 0;
    __device__ __forceinline__ int total() const { return nM * nN; }
    __device__ __forceinline__ bool next(int i, pg8::Unit& u) const {
        int pm, pn; if (c >= G || !pg8::tile_order(i * G + c, nM, nN, pm, pn)) return false;
        u.pm = pm; u.pn = pn + pn0; u.e = 0; u.lt = 0; u.nvalid = 256; return true;
    }
    __device__ __forceinline__ const char* a_ptr(const pg8::Unit& u) const { return (const char*)(ws + (WHICH == 2 ? WS_Y : WS_XB)) + (size_t)u.pm * 256 * D * 2; }
    __device__ __forceinline__ const char* b_ptr(const pg8::Unit& u) const {
        return WHICH == 2 ? (const char*)(ws + WS_WOUT) + ((size_t)l * D + u.pn * 256) * D * 2 : (const char*)(ws + WS_WIN) + ((size_t)l * INW + u.pn * 256) * D * 2; }
    __device__ __forceinline__ unsigned row_info(const pg8::Unit& u, int r) const { return ((const unsigned*)(ws + (WHICH == 2 ? WS_RSA : WS_RSTD)))[u.pm * 256 + r]; }
};
template <bool UP>
struct MoeSched {
    unsigned char* ws; int l; volatile LAS unsigned* misc; int G, c;
    __device__ __forceinline__ int total() const { return (int)misc[16 + NE] * 4; }
    __device__ __forceinline__ bool next(int i, pg8::Unit& u) const {
        const int nM = __builtin_amdgcn_readfirstlane((int)misc[16 + NE]); int pm, pn; if (c >= G || !pg8::tile_order(i * G + c, nM, 4, pm, pn)) return false;
        int ln = lane_id(); asm volatile("" : "+v"(ln)); ln &= 31;
        const int e = __popcll(__ballot((int)misc[16 + ln] <= pm)) / (int)(64 / NE) - 1;
        u.pm = pm; u.pn = pn; u.e = e; u.lt = pm - __builtin_amdgcn_readfirstlane((int)misc[16 + e]); const int rem = __builtin_amdgcn_readfirstlane((int)misc[64 + e]) - u.lt * 256; u.nvalid = rem < 256 ? rem : 256;
        return true;
    }
    __device__ __forceinline__ const char* a_ptr(const pg8::Unit& u) const { return UP ? (const char*)(ws + WS_XB) : (const char*)(ws + WS_ACT) + (size_t)u.pm * 256 * DE * 2; }
    __device__ __forceinline__ const char* b_ptr(const pg8::Unit& u) const {
        return UP ? (const char*)(ws + WS_WGU) + ((size_t)(l * NE + u.e) * 1024 + u.pn * 256) * D * 2 : (const char*)(ws + WS_WDN) + ((size_t)(l * NE + u.e) * D + u.pn * 256) * DE * 2; }
    __device__ __forceinline__ unsigned row_info(const pg8::Unit& u, int r) const { return r < u.nvalid ? ((const unsigned*)(ws + WS_LISTS))[(size_t)u.e * LCAP + u.lt * 256 + r] : (UP ? 0u : 0xffffffffu); }
};

typedef f32x4 Acc[2][2][4][2];
__device__ __forceinline__ u32x4 pack8(const f32x4 a, const f32x4 b) { u32x4 w; w.x = cvt_pk_bf16(a[0], a[1]); w.y = cvt_pk_bf16(a[2], a[3]); w.z = cvt_pk_bf16(b[0], b[1]); w.w = cvt_pk_bf16(b[2], b[3]); return w; }

__device__ __forceinline__ u32x4 xchg8(const u32x4 v) { u32x4 r;
#pragma unroll
    for (int q = 0; q < 4; ++q) r[q] = (unsigned)__builtin_amdgcn_update_dpp(0, (int)v[q], 0x128, 0xf, 0xf, false);
    return r; }
__device__ __forceinline__ float xrow16(float v, bool odd) { auto rr = __builtin_amdgcn_permlane16_swap(__float_as_uint(v), __float_as_uint(v), false, false); return __uint_as_float(odd ? rr[0] : rr[1]); }
struct EpiProj { static constexpr bool MIDSCALE = false; static constexpr int NSTORE = 16;
    unsigned char* ws;
    __device__ __forceinline__ void operator()(const Acc& acc, const pg8::Unit& u, int wr, int wc, int fr, int fq, volatile LAS unsigned* tab) const {
        unsigned char* Ob = ws + WS_PROJ + (size_t)u.pm * 256 * PW * 2; const float* cs = (const float*)(ws + WS_CS);
        const int row0 = u.pm * 256 + wr * 64 + fr;
        const int cw = u.pn * 256 + wc * 64;
        const bool rope_wave = cw < C_V;
        const bool ropel = rope_wave && fq < 2;
        const bool lo = fr < 8;
        const int colp = cw + (lo ? 0 : 32) + 8 * fq;
        f32x4 c[4][4];
#define EPROJ_LOADC(ai_, m_) do { if (ropel) { const f32x4* c4 = (const f32x4*)(cs + (size_t)((row0 + (ai_) * 128 + (m_) * 16) & (SEQ - 1)) * 16); \
            _Pragma("unroll") for (int q = 0; q < 4; ++q) c[m_][q] = c4[q]; } else { _Pragma("unroll") for (int q = 0; q < 4; ++q) c[m_][q] = (f32x4){1.f, 0.f, 1.f, 0.f}; } } while (0)
#pragma unroll
        for (int m = 0; m < 4; ++m) EPROJ_LOADC(0, m);
#pragma unroll
        for (int ai = 0; ai < 2; ++ai) {
            float r[4];
#pragma unroll
            for (int m = 0; m < 4; ++m) r[m] = __uint_as_float(tab[ai * 128 + wr * 64 + m * 16 + fr]);
#pragma unroll
            for (int m = 0; m < 4; ++m) {
                f32x4 v0 = acc[ai][0][m][0] * r[m], v1 = acc[ai][0][m][1] * r[m];
                if (rope_wave) {
                    f32x4 o0, o1;
#pragma unroll
                    for (int j = 0; j < 4; ++j) { o0[j] = xrow16(v0[j], (fq & 1) != 0); o1[j] = xrow16(v1[j], (fq & 1) != 0); }
                    const float sg = fq == 0 ? -1.f : 1.f;
                    v0[0] = v0[0] * c[m][0][0] + sg * o0[0] * c[m][0][1]; v0[1] = v0[1] * c[m][0][2] + sg * o0[1] * c[m][0][3];
                    v0[2] = v0[2] * c[m][1][0] + sg * o0[2] * c[m][1][1]; v0[3] = v0[3] * c[m][1][2] + sg * o0[3] * c[m][1][3];
                    v1[0] = v1[0] * c[m][2][0] + sg * o1[0] * c[m][2][1]; v1[1] = v1[1] * c[m][2][2] + sg * o1[1] * c[m][2][3];
                    v1[2] = v1[2] * c[m][3][0] + sg * o1[2] * c[m][3][1]; v1[3] = v1[3] * c[m][3][2] + sg * o1[3] * c[m][3][3];
                }
                if (ai == 0) EPROJ_LOADC(1, m);
                const u32x4 p0 = pack8(v0, v1), p1 = pack8(acc[ai][1][m][0] * r[m], acc[ai][1][m][1] * r[m]);
                const u32x4 rcv = xchg8(lo ? p1 : p0);
                const unsigned o = (unsigned)((wr * 64 + fr + ai * 128 + m * 16 - (lo ? 0 : 8)) * PW + colp) * 2u;
                *(u32x4*)(Ob + o) = lo ? p0 : rcv;
                *(u32x4*)(Ob + (o + (unsigned)(8 * PW * 2))) = lo ? rcv : p1;
            }
        }
#undef EPROJ_LOADC
    }
};
struct EpiCu { static constexpr bool MIDSCALE = false; static constexpr int NSTORE = 8;
    unsigned char* ws;
    __device__ __forceinline__ void operator()(const Acc& acc, const pg8::Unit& u, int wr, int wc, int fr, int fq, volatile LAS unsigned* tab) const {
        unsigned char* Ob = ws + WS_PROJ + ((size_t)u.pm * 256 * PW + P_CU + (u.pn - 5) * 128) * 2;
        const unsigned off0 = (unsigned)((wr * 64 + fr) * PW + wc * 32 + 8 * fq) * 2u;
        float r2[8];
#pragma unroll
        for (int i = 0; i < 8; ++i) { const float rs = __uint_as_float(tab[(i >> 2) * 128 + wr * 64 + (i & 3) * 16 + fr]); r2[i] = rs * rs; }
#pragma unroll
        for (int ai = 0; ai < 2; ++ai)
#pragma unroll
            for (int m = 0; m < 4; ++m) {
                const f32x4 p0 = acc[ai][0][m][0] * acc[ai][1][m][0] * r2[ai * 4 + m], p1 = acc[ai][0][m][1] * acc[ai][1][m][1] * r2[ai * 4 + m];
                *(u32x4*)(Ob + (off0 + (unsigned)((ai * 128 + m * 16) * PW * 2))) = pack8(p0, p1);
            }
    }
};
struct EpiG1 { static constexpr bool MIDSCALE = false; static constexpr int NSTORE = 8;
    unsigned char* ws;
    __device__ __forceinline__ void operator()(const Acc& acc, const pg8::Unit& u, int wr, int wc, int fr, int fq, volatile LAS unsigned* tab) const {
        if (u.pn < 5) { EpiProj E{ws}; E(acc, u, wr, wc, fr, fq, tab); } else { EpiCu E{ws}; E(acc, u, wr, wc, fr, fq, tab); }
    }
};
struct EpiResid { static constexpr bool MIDSCALE = true; static constexpr int MIDK = AW; static constexpr int NSTORE = 24;
    unsigned char* ws;
    __device__ __forceinline__ void operator()(const Acc& acc, const pg8::Unit& u, int wr, int wc, int fr, int fq, volatile LAS unsigned* tab) const {
        unsigned char* Xb = ws + WS_XB + ((size_t)u.pm * 256 * D + u.pn * 256) * 2;
        unsigned char* Sb = ws + WS_SS + ((size_t)(u.pn * 4 + wc) * T + u.pm * 256) * 4;
        const bool lo = fr < 8;
        const unsigned offx = (unsigned)((wr * 64 + fr - (lo ? 0 : 8)) * D + wc * 64 + (lo ? 0 : 32) + 8 * fq) * 2u;
        u32x4 xa[2][4], xb2[2][4];
#pragma unroll
        for (int ai = 0; ai < 2; ++ai)
#pragma unroll
            for (int m = 0; m < 4; ++m) { const unsigned o = offx + (unsigned)((ai * 128 + m * 16) * D * 2); xa[ai][m] = *(const u32x4*)(Xb + o); xb2[ai][m] = *(const u32x4*)(Xb + (o + (unsigned)(8 * D * 2))); }
#pragma unroll
        for (int ai = 0; ai < 2; ++ai) {
#pragma unroll
            for (int m = 0; m < 4; ++m) {
                const u32x4 r0 = xchg8(xa[ai][m]), r1 = xchg8(xb2[ai][m]);
                const u32x4 x0 = lo ? xa[ai][m] : r1, x1 = lo ? r0 : xb2[ai][m];
                f32x4 v00 = acc[ai][0][m][0], v01 = acc[ai][0][m][1], v10 = acc[ai][1][m][0], v11 = acc[ai][1][m][1];
                v00[0] += bflo(x0.x); v00[1] += bfhi(x0.x); v00[2] += bflo(x0.y); v00[3] += bfhi(x0.y); v01[0] += bflo(x0.z); v01[1] += bfhi(x0.z); v01[2] += bflo(x0.w); v01[3] += bfhi(x0.w);
                v10[0] += bflo(x1.x); v10[1] += bfhi(x1.x); v10[2] += bflo(x1.y); v10[3] += bfhi(x1.y); v11[0] += bflo(x1.z); v11[1] += bfhi(x1.z); v11[2] += bflo(x1.w); v11[3] += bfhi(x1.w);
                float sq = 0.f;
#pragma unroll
                for (int j = 0; j < 4; ++j) sq += v00[j] * v00[j] + v01[j] * v01[j] + v10[j] * v10[j] + v11[j] * v11[j];
                sq = xrow_sum(sq); { auto rr = __builtin_amdgcn_permlane32_swap(__float_as_uint(sq), __float_as_uint(sq), false, false); sq = __uint_as_float(rr[0]) + __uint_as_float(rr[1]); }
                if (fq == 0) *(float*)(Sb + (unsigned)((wr * 64 + fr + ai * 128 + m * 16) * 4)) = sq;
                const u32x4 p0 = pack8(v00, v01), p1 = pack8(v10, v11);
                const u32x4 rcv = xchg8(lo ? p1 : p0);
                const unsigned o = offx + (unsigned)((ai * 128 + m * 16) * D * 2);
                *(u32x4*)(Xb + o) = lo ? p0 : rcv;
                *(u32x4*)(Xb + (o + (unsigned)(8 * D * 2))) = lo ? rcv : p1;
            }
        }
    }
};
struct EpiAct { static constexpr bool MIDSCALE = false; static constexpr int NSTORE = 8;
    MoeSched<true> S;
    __device__ __forceinline__ void operator()(const Acc& acc, const pg8::Unit& u, int wr, int wc, int fr, int fq, volatile LAS unsigned* tab) const {
        unsigned char* Ab = S.ws + WS_ACT + ((size_t)u.pm * 256 * DE + u.pn * 128) * 2;
        unsigned te[8];
#pragma unroll
        for (int i = 0; i < 8; ++i) te[i] = tab[(i >> 2) * 128 + wr * 64 + (i & 3) * 16 + fr];
#pragma unroll
        for (int ai = 0; ai < 2; ++ai)
#pragma unroll
            for (int m = 0; m < 4; ++m) {
                const int r = ai * 128 + wr * 64 + m * 16 + fr; const float rs = __uint_as_float(te[ai * 4 + m] & 0xffff0000u);
                f32x4 o[2];
#pragma unroll
                for (int n = 0; n < 2; ++n)
#pragma unroll
                    for (int j = 0; j < 4; ++j) { const float g = acc[ai][0][m][n][j] * rs, up = acc[ai][1][m][n][j] * rs; o[n][j] = g * __builtin_amdgcn_rcpf(1.0f + __builtin_amdgcn_exp2f(-g * LOG2E)) * up; }
                *(u32x4*)(Ab + (unsigned)((r * DE + wc * 32 + 8 * fq) * 2)) = pack8(o[0], o[1]);
            }
    }
};
struct EpiDown { static constexpr bool MIDSCALE = false; static constexpr int NSTORE = 16;
    MoeSched<false> S;
    __device__ __forceinline__ void operator()(const Acc& acc, const pg8::Unit& u, int wr, int wc, int fr, int fq, volatile LAS unsigned* tab) const {
        unsigned char* YK = S.ws + WS_YK;
        const bool lo = fr < 8;
        const unsigned colb = (unsigned)(u.pn * 256 + wc * 64 + (lo ? 0 : 32) + 8 * fq) * 2u;
        unsigned te[8][2];
#pragma unroll
        for (int i = 0; i < 8; ++i) { te[i][0] = tab[(i >> 2) * 128 + wr * 64 + (i & 3) * 16 + (fr & 7)]; te[i][1] = tab[(i >> 2) * 128 + wr * 64 + (i & 3) * 16 + 8 + (fr & 7)]; }
#pragma unroll
        for (int ai = 0; ai < 2; ++ai)
#pragma unroll
            for (int m = 0; m < 4; ++m) {
                const unsigned q1 = te[ai * 4 + m][0], q2 = te[ai * 4 + m][1];
                const unsigned o1 = (q1 == 0xffffffffu ? (unsigned)(2 * T) : (q1 & 0xffffu)) * (unsigned)(D * 2) + colb, o2 = (q2 == 0xffffffffu ? (unsigned)(2 * T) : (q2 & 0xffffu)) * (unsigned)(D * 2) + colb;
                const u32x4 p0 = pack8(acc[ai][0][m][0], acc[ai][0][m][1]), p1 = pack8(acc[ai][1][m][0], acc[ai][1][m][1]);
                const u32x4 r0 = xchg8(p0), r1 = xchg8(p1);
                __builtin_nontemporal_store(lo ? p0 : r1, (u32x4*)(YK + o1));
                __builtin_nontemporal_store(lo ? r0 : p1, (u32x4*)(YK + o2));
                __builtin_amdgcn_sched_barrier(0);
            }
    }
};

__device__ __forceinline__ void p0_tile(const float* W, int ldw, int k0, int n0, bf16_t* WT, int Kt, int dst_row0, const float* gk, float cs, LAS unsigned char* scr, int lane, bool split = false) {
    const int r0 = lane >> 4, c = lane & 15;
    const float* src = W + (size_t)(k0 + 16 * r0) * ldw + n0 + 4 * c;
    f32x4 v[16];
#pragma unroll
    for (int i = 0; i < 16; ++i) v[i] = __builtin_nontemporal_load((const f32x4*)(src + (size_t)i * ldw));
    float g[16];
    if (gk) {
#pragma unroll
        for (int q = 0; q < 4; ++q) { const f32x4 t = *(const f32x4*)(gk + k0 + 16 * r0 + 4 * q); g[4 * q] = t[0] * cs; g[4 * q + 1] = t[1] * cs; g[4 * q + 2] = t[2] * cs; g[4 * q + 3] = t[3] * cs; }
    } else {
#pragma unroll
        for (int i = 0; i < 16; ++i) g[i] = cs;
    }
#pragma unroll
    for (int j = 0; j < 4; ++j) {
        u32x4 lo, hi2;
        lo.x = cvt_pk_bf16(v[0][j] * g[0], v[1][j] * g[1]); lo.y = cvt_pk_bf16(v[2][j] * g[2], v[3][j] * g[3]); lo.z = cvt_pk_bf16(v[4][j] * g[4], v[5][j] * g[5]); lo.w = cvt_pk_bf16(v[6][j] * g[6], v[7][j] * g[7]);
        hi2.x = cvt_pk_bf16(v[8][j] * g[8], v[9][j] * g[9]); hi2.y = cvt_pk_bf16(v[10][j] * g[10], v[11][j] * g[11]); hi2.z = cvt_pk_bf16(v[12][j] * g[12], v[13][j] * g[13]); hi2.w = cvt_pk_bf16(v[14][j] * g[14], v[15][j] * g[15]);
        const int n = 4 * c + j, sw = c & 7;
        *(LAS u32x4*)(scr + n * 128 + (((2 * r0) ^ sw) << 4)) = lo;
        *(LAS u32x4*)(scr + n * 128 + (((2 * r0 + 1) ^ sw) << 4)) = hi2;
    }
    LDS_WAIT(); asm volatile("" ::: "memory");
    const int ch = lane & 7;
#pragma unroll
    for (int i = 0; i < 8; ++i) { const int n = 8 * i + (lane >> 3);
        const u32x4 o = *(const LAS u32x4*)(scr + n * 128 + ((ch ^ ((n >> 2) & 7)) << 4));
        *(u32x4*)(WT + (size_t)(dst_row0 + n + (split ? 32 * (n >> 5) : 0)) * Kt + k0 + 8 * ch) = o; }
    LDS_WAIT(); asm volatile("" ::: "memory");
}
constexpr int CV_IN = 16 * 36, CV_OUT = 16 * 16, CV_G = NE * 128, CV_U = NE * 128, CV_D = NE * 128, CV_L = CV_IN + CV_OUT + CV_G + CV_U + CV_D;
__device__ __forceinline__ void convert_item(Frame& F, int l, int r, LAS unsigned char* scr) {
    unsigned char* ws = F.ws;
    if (r < CV_IN) { const int kb = r / 36, nb = r % 36;
        const int n0 = nb * 64;
        const int jc = n0 - C_C, ju = n0 - C_U;
        const int dst = n0 < C_C ? n0 : (n0 < C_U ? C_C + 256 * (jc / 128) + 2 * (jc % 128) : C_C + 256 * (ju / 128) + 2 * (ju % 128) + 32);
        p0_tile(in_ptr(F, 2) + (size_t)l * D * INW, INW, kb * 64, n0, (bf16_t*)(ws + WS_WIN) + (size_t)l * INW * D, D, dst, in_ptr(F, 1) + l * D, (n0 < C_K) ? QSCALE : 1.0f, scr, F.lane, n0 >= C_C); return; }
    r -= CV_IN;
    if (r < CV_OUT) { const int kb = r / 16, nb = r % 16; const int k0 = kb * 64;
        const float* gk = (k0 < AW) ? in_ptr(F, 5) + l * AW : in_ptr(F, 6) + l * CW - AW;
        p0_tile(in_ptr(F, 7) + (size_t)l * D * D, D, k0, nb * 64, (bf16_t*)(ws + WS_WOUT) + (size_t)l * D * D, D, nb * 64, gk, 1.0f, scr, F.lane); return; }
    r -= CV_OUT;
    if (r < CV_G + CV_U) { const int up = r >= CV_G; if (up) r -= CV_G; const int e = r / 128, q = r % 128, kb = q / 8, nb = q % 8; const int n0 = nb * 64;
        const float* W = in_ptr(F, up ? 14 : 13) + ((size_t)l * NE + e) * D * DE;
        p0_tile(W, DE, kb * 64, n0, (bf16_t*)(ws + WS_WGU) + ((size_t)l * NE + e) * 1024 * D, D, 256 * (n0 / 128) + 2 * (n0 % 128) + (up ? 32 : 0), in_ptr(F, 8) + l * D, 1.0f, scr, F.lane, true); return; }
    r -= CV_G + CV_U;
    { const int e = r / 128, q = r % 128, kb = q / 16, nb = q % 16;
      p0_tile(in_ptr(F, 15) + ((size_t)l * NE + e) * DE * D, D, kb * 64, nb * 64, (bf16_t*)(ws + WS_WDN) + ((size_t)l * NE + e) * D * DE, DE, nb * 64, nullptr, 1.0f, scr, F.lane); }
}
#ifndef CVX
#define CVX 4424
#define CVY 1344
#endif
#ifndef CV0
#define CV0 CVX
#endif
constexpr int CV_TOT = DEPTH * CV_L, CV_GUEND = CV_IN + CV_OUT + CV_G + CV_U;
static_assert(CVX >= CV_IN + CV_OUT && CVX <= CV_GUEND && CVY >= 0 && CVY <= CVX && CV0 >= CV_IN + CV_OUT && CV0 <= CV_GUEND, "conversion schedule");
__device__ __forceinline__ int cv_end(int l, int ph) { const int e = ph == 0 ? l * CV_L + CV_GUEND : ph == 1 ? (l + 1) * CV_L + CVY : (l + 1) * CV_L + CVX; return e < CV_TOT ? e : CV_TOT; }
__device__ __forceinline__ int cv_start(int l, int ph) { return ph == 0 ? (l == 0 ? CV0 : cv_end(l - 1, 2)) : cv_end(l, ph - 1); }
__device__ __forceinline__ int gemm_cus(int U, int G) { const int mx = (U + G - 1) / G; const int n = ((U + mx - 1) / mx + 7) & ~7; return n < G ? n : G; }
__device__ __forceinline__ void convert_work(Frame& F, unsigned* ctr, int start, int end, bool conv_cu, unsigned pk) {
    if (start >= end) return;
    const unsigned n = (unsigned)(end - start);
    volatile LAS unsigned* mb = F.MISC + 8;
    LAS unsigned char* scr = F.lds + F.wave * 16384;
    unsigned nxt = 0xffffffffu;
    if (F.tid == 0 && (conv_cu || pk < n)) nxt = __hip_atomic_fetch_add(ctr, 8u, __ATOMIC_RELAXED, __HIP_MEMORY_SCOPE_AGENT);
    for (;;) {
        if (F.tid == 0) mb[0] = nxt;
        __syncthreads();
        const unsigned base = mb[0];
        if (base >= n) break;
        if (F.tid == 0) nxt = __hip_atomic_fetch_add(ctr, 8u, __ATOMIC_RELAXED, __HIP_MEMORY_SCOPE_AGENT);
        const int it = start + (int)base + F.wave;
        if (it < end) convert_item(F, it / CV_L, it % CV_L, scr);
        __syncthreads();
    }
}
__device__ __forceinline__ void phase_prologue(Frame& F) {
    LAS unsigned char* scr = F.lds + F.wave * 16384;
    const int gw = F.vcu * NWAVES + F.wave, NGW = F.G * NWAVES;
    unsigned char* ws = F.ws;
    for (int it = gw; it < CV0; it += NGW) convert_item(F, it / CV_L, it % CV_L, scr);
    relaunder(F);
    {
        const int gt0 = F.vcu * 512 + F.tid, NGT0 = F.G * 512;
        for (int i = gt0; i < DEPTH * NE * D; i += NGT0) {
            const int l = i / (NE * D), e = (i / D) % NE, k = i % D;
            const float v = in_ptr(F, 11)[(size_t)l * D * NE + k * NE + e] * in_ptr(F, 8)[l * D + k];
            ((bf16_t*)(ws + WS_WR))[(size_t)l * 64 * D + (size_t)e * D + k] = (bf16_t)(cvt_pk_bf16(v, 0.f) & 0xffffu);
        }
    }
    const int gt = F.vcu * 512 + F.tid, NGT = F.G * 512;
    for (int i = gt; i < DEPTH * 32 * D; i += NGT) {
        const int l = i / (32 * D), rr = (i / D) % 32, k = i % D;
        float v = 0.f; if (rr < NG) v = in_ptr(F, 9)[(size_t)l * D * NG + k * NG + rr] * in_ptr(F, 8)[l * D + k];
        ((bf16_t*)(ws + WS_WR))[(size_t)l * 64 * D + (size_t)(32 + rr) * D + k] = (bf16_t)(cvt_pk_bf16(v, 0.f) & 0xffffu);
    }
    for (int i = gt; i < SEQ * 8; i += NGT) {
        const int pos = i >> 3, f = i & 7;
        const double ang = (double)pos * pow(500000.0, -(double)f / 8.0);
        ((float2*)(ws + WS_CS))[i] = make_float2((float)cos(ang), (float)sin(ang));
    }
    relaunder(F);
    const float* x = in_ptr(F, 0);
    for (int row = gw; row < T; row += NGW) {
        const f32x4* xr = (const f32x4*)(x + (size_t)row * D) + F.lane;
        f32x4 v[4]; float s = 0.f;
#pragma unroll
        for (int j = 0; j < 4; ++j) { v[j] = xr[64 * j]; s += v[j][0] * v[j][0] + v[j][1] * v[j][1] + v[j][2] * v[j][2] + v[j][3] * v[j][3]; }
        s = wave_sum(s);
        if (F.lane == 0) ((float*)(ws + WS_RSTD))[row] = rsqrtf(s * (1.0f / D) + EPS);
        u32x2* o = (u32x2*)((bf16_t*)(ws + WS_XB) + (size_t)row * D) + F.lane;
#pragma unroll
        for (int j = 0; j < 4; ++j) { u32x2 w; w.x = cvt_pk_bf16(v[j][0], v[j][1]); w.y = cvt_pk_bf16(v[j][2], v[j][3]); o[64 * j] = w; }
    }
}

typedef float f32x16 __attribute__((ext_vector_type(16)));
typedef short v4i16 __attribute__((ext_vector_type(4)));
constexpr int ATT_K_OFF = 0, ATT_V_OFF = 49152, ATT_STG_OFF = 98304;
constexpr int SSQ_WORD = 1024, RSQ_WORD = 2048;
__device__ __forceinline__ int crow(int r, int hi) { return (r & 3) + 8 * (r >> 2) + 4 * hi; }

__device__ __forceinline__ float xhalf_max(float v) { auto rr = __builtin_amdgcn_permlane32_swap(__float_as_uint(v), __float_as_uint(v), false, false); return fmaxf(__uint_as_float(rr[0]), __uint_as_float(rr[1])); }
__device__ __forceinline__ float xhalf_sum(float v) { auto rr = __builtin_amdgcn_permlane32_swap(__float_as_uint(v), __float_as_uint(v), false, false); return __uint_as_float(rr[0]) + __uint_as_float(rr[1]); }
template <int MASK>
__device__ __forceinline__ void attn_step(LAS unsigned char* lds, int kt, const bf16x8 (&qf)[4], const unsigned (&koff)[4], const unsigned (&vb)[2], int ql, int hi, float& m, float& l, f32x16 (&o)[2], f32x16& negm) {
    const LAS unsigned char* kb = lds + ATT_K_OFF + kt * 4096;
    const LAS unsigned char* vbase = lds + ATT_V_OFF + kt * 4096;
    bf16x8 kf[4];
#pragma unroll
    for (int ks = 0; ks < 4; ++ks) kf[ks] = *(const LAS bf16x8*)(kb + koff[ks]);
    f32x16 sacc = __builtin_amdgcn_mfma_f32_32x32x16_bf16(kf[0], qf[0], negm, 0, 0, 0);
#pragma unroll
    for (int ks = 1; ks < 4; ++ks) sacc = __builtin_amdgcn_mfma_f32_32x32x16_bf16(kf[ks], qf[ks], sacc, 0, 0, 0);
    v4i16 va[4], vc[4];
#pragma unroll
    for (int i = 0; i < 4; ++i) {
        va[i] = __builtin_amdgcn_ds_read_tr16_b64_v4i16((LAS v4i16*)(vbase + vb[i >> 1] + (i & 1) * 2048));
        vc[i] = __builtin_amdgcn_ds_read_tr16_b64_v4i16((LAS v4i16*)(vbase + vb[i >> 1] + (i & 1) * 2048 + 1024));
    }
    if (MASK == 1) {
#pragma unroll
        for (int r = 0; r < 16; ++r) if (crow(r, hi) < ql) sacc[r] = -1e30f;
    }
    if (MASK == 2) {
#pragma unroll
        for (int r = 0; r < 16; ++r) if (crow(r, hi) > ql) sacc[r] = -1e30f;
    }
    float mx = sacc[0];
#pragma unroll
    for (int r = 1; r < 16; ++r) mx = fmaxf(mx, sacc[r]);
    mx = xhalf_max(mx);
    if (!__all(mx <= 8.0f)) {
        asm volatile("" ::: "memory");
        const float d = fmaxf(mx, 0.f), alpha = __builtin_amdgcn_exp2f(-d);
        l *= alpha;
#pragma unroll
        for (int r = 0; r < 16; ++r) { o[0][r] *= alpha; o[1][r] *= alpha; sacc[r] -= d; negm[r] -= d; }
        m += d;
    }
    float ps = 0.f;
#pragma unroll
    for (int r = 0; r < 16; ++r) { sacc[r] = __builtin_amdgcn_exp2f(sacc[r]); ps += sacc[r]; }
    l += ps;
    bf16x8 pf[2];
#pragma unroll
    for (int s2 = 0; s2 < 2; ++s2) {
        u32x4 w; w.x = cvt_pk_bf16(sacc[8 * s2 + 0], sacc[8 * s2 + 1]); w.y = cvt_pk_bf16(sacc[8 * s2 + 2], sacc[8 * s2 + 3]); w.z = cvt_pk_bf16(sacc[8 * s2 + 4], sacc[8 * s2 + 5]); w.w = cvt_pk_bf16(sacc[8 * s2 + 6], sacc[8 * s2 + 7]);
        pf[s2] = __builtin_bit_cast(bf16x8, w);
    }
#pragma unroll
    for (int i = 0; i < 4; ++i) {
        const bf16x8 vf = (bf16x8){va[i][0], va[i][1], va[i][2], va[i][3], vc[i][0], vc[i][1], vc[i][2], vc[i][3]};
        o[i >> 1] = __builtin_amdgcn_mfma_f32_32x32x16_bf16(vf, pf[i & 1], o[i >> 1], 0, 0, 0);
    }
}

__device__ __forceinline__ void phase_mixer(Frame& F, const float* sink, const float* cw) {
    const bf16_t* P = (const bf16_t*)(F.ws + WS_PROJ);
    bf16_t* Y = (bf16_t*)(F.ws + WS_Y);
    const int tid = F.tid, lane = F.lane, w = F.wave;
    const int ql = lane & 31, hi = lane >> 5;
    LAS unsigned char* lds = F.lds;
    volatile LAS float* ssq = (volatile LAS float*)(F.MISC + SSQ_WORD);
    volatile LAS float* rsq = (volatile LAS float*)(F.MISC + RSQ_WORD);
    unsigned koff[4], vb[2];
#pragma unroll
    for (int ks = 0; ks < 4; ++ks) koff[ks] = (unsigned)(ql * 128 + (((2 * ks + hi) ^ ((ql >> 1) & 7)) << 4));
    { const int g = (lane >> 4) & 1, li = lane & 15, q = li >> 2, p = li & 3, sw = (q >> 1) & 1;
      vb[0] = (unsigned)((4 * hi + q) * 128 + 64 * sw + 32 * g + 8 * p); vb[1] = (unsigned)((4 * hi + q) * 128 + 64 * (1 - sw) + 32 * g + 8 * p); }
    for (int unit = F.vcu; unit < BATCH * (SEQ / 128); unit += F.G) {
        const int b = unit / (SEQ / 128), n = unit % (SEQ / 128);
        const size_t tok0 = (size_t)b * SEQ + (size_t)n * 128;
#pragma unroll 1
        for (int part = 0; part < 2; ++part) {
        if ((part == 0) != ((F.vcu & 1) != 0)) {
        u32x4 kv[6], vv[6];
#define ATT_LOAD_K(kvh_) do { _Pragma("unroll") for (int i = 0; i < 6; ++i) { const int idx = tid + 512 * i, key = idx >> 3, ch = idx & 7; \
            const int kpos = (n - 1) * 128 + key; const int kc = kpos < 0 ? 0 : (kpos >= SEQ ? SEQ - 1 : kpos); \
            kv[i] = *(const u32x4*)(P + ((size_t)b * SEQ + kc) * PW + (kvh_) * HD + ch * 8 + C_K); } } while (0)
#define ATT_LOAD_V(kvh_) do { _Pragma("unroll") for (int i = 0; i < 6; ++i) { const int idx = tid + 512 * i, key = idx >> 3, ch = idx & 7; \
            const int kpos = (n - 1) * 128 + key; const int kc = kpos < 0 ? 0 : (kpos >= SEQ ? SEQ - 1 : kpos); \
            vv[i] = *(const u32x4*)(P + ((size_t)b * SEQ + kc) * PW + (kvh_) * HD + ch * 8 + C_V); } } while (0)
        { int tid = F.tid; asm volatile("" : "+v"(tid)); ATT_LOAD_K(0); ATT_LOAD_V(0); }
#pragma unroll
        for (int kvh = 0; kvh < 2; ++kvh) {
            int tid = F.tid; asm volatile("" : "+v"(tid));
            if (kvh == 1) ATT_LOAD_V(1);
            __syncthreads();
            const int head = kvh * 4 + (w >> 1), qh = w & 1;
#pragma unroll
            for (int i = 0; i < 6; ++i) {
                const int idx = tid + 512 * i, key = idx >> 3, ch = idx & 7;
                const int kpos = (n - 1) * 128 + key; const bool ok = kpos >= 0 && kpos < SEQ;
                const u32x4 z = (u32x4){0u, 0u, 0u, 0u};
                *(LAS u32x4*)(lds + ATT_K_OFF + key * 128 + ((ch ^ ((key >> 1) & 7)) << 4)) = ok ? kv[i] : z;
                *(LAS u32x4*)(lds + ATT_V_OFF + key * 128 + ((ch ^ (((key >> 1) & 1) << 2)) << 4)) = ok ? vv[i] : z;
            }
            if (kvh == 0) ATT_LOAD_K(1);
            __syncthreads();
            const float sk = sink[head] * LOG2E;
#pragma unroll
            for (int qt = 0; qt < 2; ++qt) {
                int lane_q = lane; asm volatile("" : "+v"(lane_q)); const int ql = lane_q & 31, hi = lane_q >> 5;
                const int q0 = 64 * qh + 32 * qt;
                const bf16_t* qrow = P + (tok0 + q0 + ql) * PW + C_Q + head * HD + 8 * hi;
                bf16x8 qf[4];
#pragma unroll
                for (int ks = 0; ks < 4; ++ks) qf[ks] = *(const bf16x8*)(qrow + 16 * ks);
                float m = sk, l = hi == 0 ? 1.f : 0.f;
                f32x16 negm;
#pragma unroll
                for (int r = 0; r < 16; ++r) negm[r] = -sk;
                f32x16 o[2];
#pragma unroll
                for (int r = 0; r < 16; ++r) { o[0][r] = 0.f; o[1][r] = 0.f; }
                const int kt0 = q0 >> 5;
                if (n - 1 + (kt0 >> 2) >= 0) attn_step<1>(lds, kt0, qf, koff, vb, ql, hi, m, l, o, negm);
#pragma unroll 1
                for (int j = 1; j < 8; ++j) { const int kt = kt0 + j; const int gb = n - 1 + (kt >> 2); if (gb >= 0 && gb < SEQ / 128) attn_step<0>(lds, kt, qf, koff, vb, ql, hi, m, l, o, negm); }
                if (n - 1 + ((kt0 + 8) >> 2) < SEQ / 128) attn_step<2>(lds, kt0 + 8, qf, koff, vb, ql, hi, m, l, o, negm);
                const float lt = xhalf_sum(l);
                const float inv = 1.0f / lt;
                float sq = 0.f;
#pragma unroll
                for (int dt = 0; dt < 2; ++dt)
#pragma unroll
                    for (int r = 0; r < 16; ++r) { o[dt][r] *= inv; sq += o[dt][r] * o[dt][r]; }
                sq = xhalf_sum(sq);
                if (hi == 0) ssq[head * 128 + q0 + ql] = sq;
                {   LAS unsigned char* stg = lds + ATT_STG_OFF + w * 4096;
#pragma unroll
                    for (int dt = 0; dt < 2; ++dt)
#pragma unroll
                        for (int g = 0; g < 4; ++g) {
                            const int c8 = 4 * dt + g;
                            u32x2 wv; wv.x = cvt_pk_bf16(o[dt][4 * g], o[dt][4 * g + 1]); wv.y = cvt_pk_bf16(o[dt][4 * g + 2], o[dt][4 * g + 3]);
                            *(LAS u32x2*)(stg + ql * 128 + ((c8 ^ (ql & 7)) << 4) + 8 * hi) = wv; }
                    asm volatile("s_waitcnt lgkmcnt(0)" ::: "memory");
#pragma unroll
                    for (int i = 0; i < 4; ++i) { const int row = 8 * i + (lane_q >> 3), ch = lane_q & 7;
                        const u32x4 v = *(const LAS u32x4*)(stg + row * 128 + ((ch ^ (row & 7)) << 4));
                        *(u32x4*)(Y + (tok0 + q0 + row) * D + head * HD + 8 * ch) = v; }
                    asm volatile("s_waitcnt lgkmcnt(0)" ::: "memory");
                }
            }
        }
        __syncthreads();
        if (tid < 128) { float s = 0.f;
#pragma unroll
            for (int h = 0; h < 8; ++h) s += ssq[h * 128 + tid];
            ((float*)(F.ws + WS_RSA))[tok0 + tid] = rsqrtf(s * (1.0f / AW) + EPS); }
        } else
        {
            int lane_c = lane; asm volatile("" : "+v"(lane_c));
            float cwv[3][8];
#pragma unroll
            for (int k = 0; k < 3; ++k) { const f32x4 a = *(const f32x4*)(cw + k * CW + 8 * lane_c), b2 = *(const f32x4*)(cw + k * CW + 8 * lane_c + 4);
#pragma unroll
                for (int jj = 0; jj < 4; ++jj) { cwv[k][jj] = a[jj]; cwv[k][4 + jj] = b2[jj]; } }
#pragma unroll 1
            for (int bt = 0; bt < 2; ++bt) {
                const int p0 = n * 128 + 16 * w + 8 * bt;
                const bf16_t* pr0 = P + (tok0 + 16 * w + 8 * bt) * PW;
                const u32x4 zero = (u32x4){0u, 0u, 0u, 0u};
                u32x4 cc[10], bb[8];
#pragma unroll
                for (int r = 0; r < 10; ++r) { const int pos = p0 - 1 + r; const bool ok = pos >= 0 && pos < SEQ;
                    cc[r] = ok ? *(const u32x4*)(pr0 + (ptrdiff_t)(r - 1) * PW + P_CU + 8 * lane_c) : zero; }
#pragma unroll
                for (int r = 0; r < 8; ++r) bb[r] = *(const u32x4*)(pr0 + (size_t)r * PW + C_B + 8 * lane_c);
                float cu[10][8];
#pragma unroll
                for (int r = 0; r < 10; ++r)
#pragma unroll
                    for (int wi = 0; wi < 4; ++wi) { cu[r][2 * wi] = bflo(cc[r][wi]); cu[r][2 * wi + 1] = bfhi(cc[r][wi]); }
#pragma unroll
                for (int r = 0; r < 8; ++r) {
                    float yc[8]; float s2 = 0.f;
#pragma unroll
                    for (int jj = 0; jj < 8; ++jj) {
                        const float gb = (jj & 1) ? bfhi(bb[r][jj >> 1]) : bflo(bb[r][jj >> 1]);
                        yc[jj] = gb * (cwv[0][jj] * cu[r][jj] + cwv[1][jj] * cu[r + 1][jj] + cwv[2][jj] * cu[r + 2][jj]); s2 += yc[jj] * yc[jj];
                    }
                    s2 = wave_sum(s2);
                    const float rstd = rsqrtf(s2 * (1.0f / CW) + EPS);
                    u32x4 wv; wv.x = cvt_pk_bf16(yc[0] * rstd, yc[1] * rstd); wv.y = cvt_pk_bf16(yc[2] * rstd, yc[3] * rstd); wv.z = cvt_pk_bf16(yc[4] * rstd, yc[5] * rstd); wv.w = cvt_pk_bf16(yc[6] * rstd, yc[7] * rstd);
                    *(u32x4*)(Y + (tok0 + 16 * w + 8 * bt + r) * D + AW + 8 * lane_c) = wv;
                }
            }
        }
        }
    }
}


constexpr int RT_PITCH = 2064;
constexpr int LCNT_WORD = 2304, GBASE_WORD = 2368;
__device__ __forceinline__ void router_stage(Frame& F, int l) {
    const bf16_t* WR = (const bf16_t*)(F.ws + WS_WR) + (size_t)l * 64 * D;
    const int tid = F.tid; LAS unsigned char* lds = F.lds;
    __syncthreads();
    u32x4 wv[9];
#pragma unroll
    for (int j = 0; j < 9; ++j) { const int i = tid + 512 * j; wv[j] = *(const u32x4*)(WR + (size_t)(i >> 7) * D + (i & 127) * 8); }
#pragma unroll
    for (int j = 0; j < 9; ++j) { const int i = tid + 512 * j; *(LAS u32x4*)(lds + (i >> 7) * RT_PITCH + (i & 127) * 16) = wv[j]; }
}
__device__ __forceinline__ void phase_router(Frame& F, int l, const float* brg, const float* bre) {
    const bf16_t* XB = (const bf16_t*)(F.ws + WS_XB);
    const float* SS = (const float*)(F.ws + WS_SS);
    float* RSTD = (float*)(F.ws + WS_RSTD); float* GATES = (float*)(F.ws + WS_GATES); int* LISTS = (int*)(F.ws + WS_LISTS);
    unsigned* cnt = F.ctl + CW_CNT + l * NE * 64;
    const int tid = F.tid, lane = F.lane, w = F.wave, ql = lane & 31, hi = lane >> 5;
    LAS unsigned char* lds = F.lds;
    volatile LAS unsigned* lcnt = F.MISC + LCNT_WORD; volatile LAS unsigned* gbase = F.MISC + GBASE_WORD;
    if (tid < NE) lcnt[tid] = 0u;
    __syncthreads();
    for (int unit = F.vcu; unit < T / 128; unit += F.G) {
        int e0 = 0, e1 = 0; unsigned rank0 = 0, rank1 = 0; float g0 = 0.f, g1 = 0.f, rstd = 0.f;
        const int t = unit * 128 + 32 * w + ql;
        if (w < 4) {
            f32x16 acc0, acc1;
#pragma unroll
            for (int r = 0; r < 16; ++r) { acc0[r] = 0.f; acc1[r] = 0.f; }
            const bf16_t* xr = XB + (size_t)t * D + 32 * hi;
            const LAS unsigned char* a0p = lds + ql * RT_PITCH + 64 * hi;
            const LAS unsigned char* a1p = lds + (32 + (ql < 3 ? ql : 3)) * RT_PITCH + 64 * hi;
#pragma unroll 4
            for (int a = 0; a < 16; ++a) {
                bf16x8 xv[4];
#pragma unroll
                for (int i = 0; i < 4; ++i) xv[i] = *(const bf16x8*)(xr + 64 * a + 8 * i);
#pragma unroll
                for (int i = 0; i < 4; ++i) {
                    const bf16x8 w0 = *(const LAS bf16x8*)(a0p + 128 * a + 16 * i), w1 = *(const LAS bf16x8*)(a1p + 128 * a + 16 * i);
                    acc0 = __builtin_amdgcn_mfma_f32_32x32x16_bf16(w0, xv[i], acc0, 0, 0, 0);
                    acc1 = __builtin_amdgcn_mfma_f32_32x32x16_bf16(w1, xv[i], acc1, 0, 0, 0);
                }
            }
            { float sv[8];
#pragma unroll
              for (int j = 0; j < 8; ++j) sv[j] = SS[(size_t)(8 * hi + j) * T + t];
              float ssum = (sv[0] + sv[1]) + (sv[2] + sv[3]) + (sv[4] + sv[5]) + (sv[6] + sv[7]); { auto rr = __builtin_amdgcn_permlane32_swap(__float_as_uint(ssum), __float_as_uint(ssum), false, false); ssum = __uint_as_float(rr[0]) + __uint_as_float(rr[1]); } rstd = rsqrtf(ssum * (1.0f / D) + EPS); }
            float gl[4];
#pragma unroll
            for (int g = 0; g < 4; ++g) { const float o = xhalf_other(acc1[g], hi != 0); gl[g] = (hi ? o : acc1[g]) * rstd + brg[g]; }
            int grp = 0; float gm = gl[0];
#pragma unroll
            for (int g = 1; g < 4; ++g) if (gl[g] > gm) { gm = gl[g]; grp = g; }
            float den = 0.f;
#pragma unroll
            for (int g = 0; g < 4; ++g) den += __expf(gl[g] - gm);
            const float pg = 1.0f / den;
            float own[4], oth[4], el[8];
#pragma unroll
            for (int i = 0; i < 4; ++i) { const float v = grp == 0 ? acc0[i] : grp == 1 ? acc0[4 + i] : grp == 2 ? acc0[8 + i] : acc0[12 + i]; own[i] = v * rstd + bre[8 * grp + 4 * hi + i]; }
#pragma unroll
            for (int i = 0; i < 4; ++i) oth[i] = xhalf_other(own[i], hi != 0);
#pragma unroll
            for (int i = 0; i < 4; ++i) { el[i] = hi ? oth[i] : own[i]; el[4 + i] = hi ? own[i] : oth[i]; }
            int i1 = 0; float l1 = el[0];
#pragma unroll
            for (int i = 1; i < 8; ++i) if (el[i] > l1) { l1 = el[i]; i1 = i; }
            int i2 = -1; float l2 = -3.0e38f;
#pragma unroll
            for (int i = 0; i < 8; ++i) if (i != i1 && el[i] > l2) { l2 = el[i]; i2 = i; }
            if (i2 < 0) i2 = (i1 + 1) & 7;
            const float ex = __expf(l2 - l1);
            e0 = grp * 8 + i1; e1 = grp * 8 + i2; g0 = pg / (1.0f + ex); g1 = pg * ex / (1.0f + ex);
            if (hi == 0) { rank0 = __hip_atomic_fetch_add((LAS unsigned*)(lcnt + e0), 1u, __ATOMIC_RELAXED, __HIP_MEMORY_SCOPE_WORKGROUP); rank1 = __hip_atomic_fetch_add((LAS unsigned*)(lcnt + e1), 1u, __ATOMIC_RELAXED, __HIP_MEMORY_SCOPE_WORKGROUP); }
        }
        __syncthreads();
        if (tid < NE) { const unsigned n = lcnt[tid]; gbase[tid] = n ? atomicAdd(cnt + tid * 64, n) : 0u; lcnt[tid] = 0u; }
        __syncthreads();
        if (w < 4 && hi == 0) {
            const unsigned rb = cvt_pk_bf16(0.f, rstd) & 0xffff0000u;
            LISTS[(size_t)e0 * LCAP + gbase[e0] + rank0] = (int)(rb | (unsigned)(t * 2)); LISTS[(size_t)e1 * LCAP + gbase[e1] + rank1] = (int)(rb | (unsigned)(t * 2 + 1));
            *(float2*)(GATES + t * 2) = make_float2(g0, g1);
        }
    }
}

__device__ __forceinline__ void phase_combine_final(Frame& F, const float* gfinal, float* out) {
    const int gw = F.vcu * NWAVES + F.wave, NGW = F.G * NWAVES;
    const bf16_t* XB = (const bf16_t*)(F.ws + WS_XB); const bf16_t* YK = (const bf16_t*)(F.ws + WS_YK); const float* GATES = (const float*)(F.ws + WS_GATES);
    f32x4 gf[4];
#pragma unroll
    for (int q = 0; q < 4; ++q) gf[q] = *(const f32x4*)(gfinal + 4 * F.lane + 256 * q);
    for (int t = gw; t < T; t += NGW) {
        const u32x2* xr = (const u32x2*)(XB + (size_t)t * D) + F.lane;
        const u32x2* y0 = (const u32x2*)(YK + (size_t)(2 * t) * D) + F.lane; const u32x2* y1 = (const u32x2*)(YK + (size_t)(2 * t + 1) * D) + F.lane;
        float v[4][4]; float s = 0.f; const float ga = GATES[2 * t], gb = GATES[2 * t + 1];
#pragma unroll
        for (int q = 0; q < 4; ++q) { const u32x2 a = xr[64 * q], b = y0[64 * q], c = y1[64 * q];
#pragma unroll
            for (int i = 0; i < 2; ++i) { v[q][2 * i] = bflo(a[i]) + ga * bflo(b[i]) + gb * bflo(c[i]); v[q][2 * i + 1] = bfhi(a[i]) + ga * bfhi(b[i]) + gb * bfhi(c[i]); s += v[q][2 * i] * v[q][2 * i] + v[q][2 * i + 1] * v[q][2 * i + 1]; } }
        s = wave_sum(s);
        const float rstd = rsqrtf(s * (1.0f / D) + EPS);
#pragma unroll
        for (int q = 0; q < 4; ++q) { f32x4 o;
#pragma unroll
            for (int i = 0; i < 4; ++i) o[i] = v[q][i] * rstd * gf[q][i];
            __builtin_nontemporal_store(o, (f32x4*)(out + (size_t)t * D + 4 * F.lane + 256 * q)); }
    }
}
__device__ __forceinline__ void phase_combine(Frame& F, const float* gfinal, float* out) {
    const int gw = F.vcu * NWAVES + F.wave, NGW = F.G * NWAVES;
    bf16_t* XB = (bf16_t*)(F.ws + WS_XB); const bf16_t* YK = (const bf16_t*)(F.ws + WS_YK); float* RSTD = (float*)(F.ws + WS_RSTD); const float* GATES = (const float*)(F.ws + WS_GATES);
    f32x4 gf[2][2];
#pragma unroll
    for (int j = 0; j < 2; ++j) { const int c0 = 8 * (F.lane + 64 * j); gf[j][0] = gfinal ? *(const f32x4*)(gfinal + c0) : (f32x4){0.f, 0.f, 0.f, 0.f}; gf[j][1] = gfinal ? *(const f32x4*)(gfinal + c0 + 4) : (f32x4){0.f, 0.f, 0.f, 0.f}; }
    for (int t = gw; t < T; t += NGW) {
        u32x4* xr = (u32x4*)(XB + (size_t)t * D) + F.lane;
        const u32x4* y0 = (const u32x4*)(YK + (size_t)(2 * t) * D) + F.lane; const u32x4* y1 = (const u32x4*)(YK + (size_t)(2 * t + 1) * D) + F.lane;
        float v[2][8]; float s = 0.f; const float ga = GATES[2 * t], gb = GATES[2 * t + 1];
#pragma unroll
        for (int j = 0; j < 2; ++j) { const u32x4 a = xr[64 * j], b = y0[64 * j], c = y1[64 * j];
#pragma unroll
            for (int i = 0; i < 4; ++i) { v[j][2 * i] = bflo(a[i]) + ga * bflo(b[i]) + gb * bflo(c[i]); v[j][2 * i + 1] = bfhi(a[i]) + ga * bfhi(b[i]) + gb * bfhi(c[i]); s += v[j][2 * i] * v[j][2 * i] + v[j][2 * i + 1] * v[j][2 * i + 1]; } }
        s = wave_sum(s);
        const float rstd = rsqrtf(s * (1.0f / D) + EPS);
        if (gfinal) {
#pragma unroll
            for (int j = 0; j < 2; ++j) { const int c0 = 8 * (F.lane + 64 * j); const f32x4 g0 = gf[j][0], g1 = gf[j][1];
                f32x4 o0, o1;
#pragma unroll
                for (int i = 0; i < 4; ++i) { o0[i] = v[j][i] * rstd * g0[i]; o1[i] = v[j][4 + i] * rstd * g1[i]; }
                __builtin_nontemporal_store(o0, (f32x4*)(out + (size_t)t * D + c0)); __builtin_nontemporal_store(o1, (f32x4*)(out + (size_t)t * D + c0 + 4)); }
        } else {
            if (F.lane == 0) RSTD[t] = rstd;
#pragma unroll
            for (int j = 0; j < 2; ++j) { u32x4 w; w.x = cvt_pk_bf16(v[j][0], v[j][1]); w.y = cvt_pk_bf16(v[j][2], v[j][3]); w.z = cvt_pk_bf16(v[j][4], v[j][5]); w.w = cvt_pk_bf16(v[j][6], v[j][7]); __builtin_nontemporal_store(w, xr + 64 * j); }
        }
    }
}

__device__ __forceinline__ void moe_setup(Frame& F, int l) {
    __syncthreads();
    if (F.tid < 64) {
        const int e = F.tid & 31;
        const unsigned c = __hip_atomic_load(F.ctl + CW_CNT + (l * NE + e) * 64, __ATOMIC_RELAXED, __HIP_MEMORY_SCOPE_AGENT);
        const unsigned tl = (c + 255u) / 256u;
        unsigned inc = tl;
#pragma unroll
        for (int o = 1; o < 32; o <<= 1) { const unsigned v = (unsigned)__builtin_amdgcn_ds_bpermute(((F.tid - o) & 63) << 2, (int)inc); if (e >= o) inc += v; }
        if (F.tid < 32) { F.MISC[64 + e] = c; F.MISC[16 + e] = inc - tl; if (e == 31) F.MISC[16 + NE] = inc; }
    }
    __syncthreads();
}

constexpr int N_PHASES = 1 + 7 * DEPTH;
__global__ void __launch_bounds__(NWAVES * 64, 2) mk_fwd(Args args) {
    extern __shared__ __attribute__((aligned(16))) unsigned char lds[];
    Frame F;
    F.lds = (LAS unsigned char*)lds; F.MISC = (volatile LAS unsigned*)(F.lds + MISC_OFF);
    F.wave = __builtin_amdgcn_readfirstlane((int)threadIdx.x >> 6); F.lane = lane_id(); F.tid = F.wave * 64 + F.lane;
    F.G = gridDim.x; { const int bx = blockIdx.x; F.vcu = (F.G % 8 == 0) ? (bx % 8) * (F.G / 8) + bx / 8 : bx; }
    F.ws = args.ws; F.ctl = (unsigned*)(args.ws + WS_CTL); F.cx = (int)blockIdx.x; F.uni = 0; F.xcc = 0; F.xord = 0;
    for (int u = F.tid; u < 512; u += NWAVES * 64) F.MISC[u] = 0u;
    __syncthreads();
    if (F.tid == 0) {
        volatile LAS unsigned long long* pt = (volatile LAS unsigned long long*)(F.MISC + 128);
#define PT_(i) pt[i] = (unsigned long long)(uintptr_t)args.in[i];
        PT_(0) PT_(1) PT_(2) PT_(3) PT_(4) PT_(5) PT_(6) PT_(7) PT_(8) PT_(9) PT_(10) PT_(11) PT_(12) PT_(13) PT_(14) PT_(15) PT_(16)
#undef PT_
        pt[17] = (unsigned long long)(uintptr_t)args.out;
    }
    __syncthreads();
#if MK_ONE_LAUNCH
    XcdBarrier bar = xcd_barrier_post(F.ctl + CW_BAR, F.MISC + 0, F.tid);
    F.xcc = (int)bar.x;
#define GRID_BAR() xcd_barrier(bar, F.wave)
#else
#define GRID_BAR() do {} while (0)
#endif
    const int lo = args.ph_lo, hi = args.ph_hi;
#define IN(k) (lo <= (k) && (k) < hi)
#define SEAM(k) do { if (IN(k) && IN((k) + 1)) GRID_BAR(); } while (0)
#define LSEAM(k, slot) do { if (IN(k) && IN((k) + 1)) { if (F.uni) xcc_local_barrier(F.ctl + CW_XL + ((slot) * 16 + F.xcc) * 64, F.ctl + CW_BAR, F.wave); else GRID_BAR(); } } while (0)
#define PSEAM(k, slot) do { if (IN(k) && IN((k) + 1)) { if (F.uni) xcc_pair_barrier(F.ctl + CW_XL + ((11 + (slot)) * 16 + F.xcc) * 64, F.ctl + CW_XL + ((15 + (slot)) * 16 + (F.xord >> 1)) * 64, F.ctl + CW_BAR, F.wave); else GRID_BAR(); } } while (0)
    if (IN(0)) { relaunder(F); phase_prologue(F); SEAM(0); }
#if MK_ONE_LAUNCH
    if (IN(0) && IN(1)) {
        if (__builtin_amdgcn_readfirstlane((int)F.MISC[4]) != 0) {
            const int rank = __builtin_amdgcn_readfirstlane((int)F.MISC[2]), xord = __builtin_amdgcn_readfirstlane((int)F.MISC[3]);
            F.vcu = xord * 32 + rank; F.cx = rank * 8 + xord; F.uni = 1; F.xord = xord;
        }
    }
#endif
    for (int l = 0; l < DEPTH; ++l) {
        const int p = 1 + 7 * l;
        if (IN(p)) { relaunder(F);
            { const int ng = gemm_cus((T / 256) * 9, F.G); unsigned* ctr = F.ctl + CW_CONV + (l * 3 + 0) * 64;
              DenseSched<13> S{F.ws, l, ng, F.bx}; EpiG1 E{F.ws};
              const unsigned pk = pg8::gemm_phase<EpiG1, DenseSched<13>, false, true>(F.lds, F.MISC + 256, D, S, E, F.wave, ctr);
              relaunder(F);
              convert_work(F, ctr, cv_start(l, 0), cv_end(l, 0), F.bx >= ng, pk); }
            PSEAM(p, l);
        }
        if (IN(p + 1)) { relaunder(F); phase_mixer(F, in_ptr(F, 3) + l * NH, in_ptr(F, 4) + (size_t)l * 3 * CW); LSEAM(p + 1, l * 2); }
        if (IN(p + 2)) { relaunder(F);
            DenseSched<2> S{F.ws, l, F.G, F.bx};
            EpiResid E{F.ws};
            pg8::gemm_phase<EpiResid, DenseSched<2>, false, true>(F.lds, F.MISC + 256, D, S, E, F.wave);
            relaunder(F); router_stage(F, l);
            LSEAM(p + 2, l * 2 + 1);
        }
        if (IN(p + 3)) { relaunder(F); if (!IN(p + 2)) router_stage(F, l); phase_router(F, l, in_ptr(F, 10) + l * NG, in_ptr(F, 12) + l * NE); SEAM(p + 3); }
        if (IN(p + 4)) { relaunder(F);
            moe_setup(F, l);
            const int ng = gemm_cus((int)F.MISC[16 + NE] * 4, F.G); unsigned* ctr = F.ctl + CW_CONV + (l * 3 + 1) * 64;
            MoeSched<true> S{F.ws, l, F.MISC, ng, F.bx};
            EpiAct E{S};
            const unsigned pk = pg8::gemm_phase<EpiAct, MoeSched<true>, true, true>(F.lds, F.MISC + 256, D, S, E, F.wave, ctr);
            relaunder(F);
            convert_work(F, ctr, cv_start(l, 1), cv_end(l, 1), F.bx >= ng, pk);
            SEAM(p + 4);
        }
        if (IN(p + 5)) { relaunder(F);
            const int ng = gemm_cus((int)F.MISC[16 + NE] * 4, F.G); unsigned* ctr = F.ctl + CW_CONV + (l * 3 + 2) * 64;
            MoeSched<false> S{F.ws, l, F.MISC, ng, F.bx};
            EpiDown E{S};
            const unsigned pk = pg8::gemm_phase<EpiDown, MoeSched<false>, false, true>(F.lds, F.MISC + 256, DE, S, E, F.wave, ctr);
            relaunder(F);
            convert_work(F, ctr, cv_start(l, 2), cv_end(l, 2), F.bx >= ng, pk);
            SEAM(p + 5);
        }
        if (IN(p + 6)) { relaunder(F); if (l == DEPTH - 1) phase_combine_final(F, in_ptr(F, 16), (float*)in_ptr(F, 17)); else phase_combine(F, nullptr, nullptr); if (l < DEPTH - 1) SEAM(p + 6); }
    }
}

extern "C" void kernel_launch(void* const* d_in, const int* in_sizes, int n_in, void* d_out, int out_size, void* d_ws, size_t ws_size, hipStream_t stream) {
    static int grid = 0;
    if (grid == 0) {
        if (n_in != 17 || ws_size < WS_END) { fprintf(stderr, "kernel_launch: bad inputs (n_in %d, ws %zu)\n", n_in, ws_size); grid = -1; return; }
        int dev = 0, cus = 0, per_cu = 0;
        if (hipGetDevice(&dev) != hipSuccess || hipDeviceGetAttribute(&cus, hipDeviceAttributeMultiprocessorCount, dev) != hipSuccess) { grid = -1; return; }
        if (hipFuncSetAttribute((const void*)mk_fwd, hipFuncAttributeMaxDynamicSharedMemorySize, LDS_BYTES) != hipSuccess) { fprintf(stderr, "kernel_launch: hipFuncSetAttribute failed\n"); grid = -1; return; }
        if (hipOccupancyMaxActiveBlocksPerMultiprocessor(&per_cu, (const void*)mk_fwd, NWAVES * 64, LDS_BYTES) != hipSuccess || per_cu < 1) { fprintf(stderr, "kernel_launch: occupancy query says %d\n", per_cu); per_cu = 1; }
        (void)hipGetLastError();
        grid = cus;
    }
    if (grid < 0) return;
    (void)hipMemsetAsync((char*)d_ws + WS_CTL, 0, CTL_ZERO_BYTES, stream);
    Args a; memset(&a, 0, sizeof(a));
    for (int i = 0; i < 17; ++i) a.in[i] = (const float*)d_in[i];
    a.out = (float*)d_out; a.ws = (unsigned char*)d_ws;
#if MK_ONE_LAUNCH
    a.ph_lo = 0; a.ph_hi = N_PHASES;
    hipLaunchKernelGGL(mk_fwd, dim3(grid), dim3(NWAVES * 64), LDS_BYTES, stream, a);
#else
    for (int p = 0; p < N_PHASES; ++p) { a.ph_lo = p; a.ph_hi = p + 1; hipLaunchKernelGGL(mk_fwd, dim3(grid), dim3(NWAVES * 64), LDS_BYTES, stream, a); }
#endif
}
```
